# Optimizing an MI355X kernel written in HIP

```python
import jax, jax.numpy as jnp
from jax import lax
import numpy as np

D_MODEL = 1024
BATCH = 32
SEQ = 2048
DEPTH = 4
DEC_BATCH = 8
DEC_SEQ = 16
PAST_LEN = 1024

CHUNK = 64
N_EVEN = (DEPTH + 1) // 2
N_ODD = DEPTH // 2
SC_WIDTH = D_MODEL // 2
SC_CONV = 3
FOX_HEADS = 8
HEAD_DIM = 64
FOX_WIDTH = FOX_HEADS * HEAD_DIM
Q_BLOCK = 128
EVEN_IN = 3 * SC_WIDTH + 3 * FOX_WIDTH + FOX_HEADS
FORGET_BIAS_INIT = 3.0
D_INNER = 2 * D_MODEL
SSM_HEAD_DIM = 64
SSM_HEADS = D_INNER // SSM_HEAD_DIM
SSM_GROUPS = 4
D_STATE = 128
SSM_CONV = 4
CONV_DIM = D_INNER + 2 * SSM_GROUPS * D_STATE
ODD_IN = D_INNER + CONV_DIM + SSM_HEADS
D_FF = 2816
FFN_CONV = 3
EPS = 1e-6
RESID_SCALE = (2 * DEPTH) ** -0.5

kernel_name = 'hybrid_stream_shortconv_fox_ssd_convffn'


def rms_norm(x, gain):
    xf = x.astype(jnp.float32)
    y = xf * lax.rsqrt(jnp.mean(xf * xf, axis=-1, keepdims=True) + EPS)
    return (y * gain.astype(jnp.float32)).astype(x.dtype)


def causal_dwconv(x, state, w, bias=None):
    width = w.shape[0]
    length = x.shape[1]
    xp = jnp.concatenate([state.astype(x.dtype), x], axis=1)
    y = xp[:, 0:length] * w[0]
    for j in range(1, width):
        y = y + xp[:, j:j + length] * w[j]
    if bias is not None:
        y = y + bias
    return y, xp[:, length:]


def fox_attention(q, k, v, logf, n_past):
    b, lq, nh, hd = q.shape
    lk = k.shape[1]
    cum = jnp.cumsum(logf.astype(jnp.float32), axis=1)
    cum_k = jnp.swapaxes(cum, 1, 2)
    cum_q = cum_k[:, :, n_past:]
    qb = Q_BLOCK if lq % Q_BLOCK == 0 else lq
    nb = lq // qb
    q_blocks = jnp.moveaxis(q.reshape(b, nb, qb, nh, hd), 1, 0)
    c_blocks = jnp.moveaxis(cum_q.reshape(b, nh, nb, qb), 2, 0)
    pos_blocks = (n_past + jnp.arange(lq)).reshape(nb, qb)
    kpos = jnp.arange(lk)
    scale = HEAD_DIM ** -0.5

    def block(args):
        qblk, cblk, pblk = args
        s = jnp.einsum('bqhd,bkhd->bhqk', qblk, k).astype(jnp.float32) * scale
        s = s + cblk[..., None] - cum_k[:, :, None, :]
        s = jnp.where(kpos[None, :] <= pblk[:, None], s, -jnp.inf)
        p = jax.nn.softmax(s, axis=-1)
        return jnp.einsum('bhqk,bkhd->bqhd', p.astype(v.dtype), v)

    out = lax.map(block, (q_blocks, c_blocks, pos_blocks))
    return jnp.moveaxis(out, 0, 1).reshape(b, lq, nh, hd)


def ssd_scan(x, dt, a, bmat, cmat, h0, chunk):
    f32 = jnp.float32
    b, length, nh, hp = x.shape
    g, n = bmat.shape[2], bmat.shape[3]
    r = nh // g
    nc = length // chunk
    xc = x.astype(f32).reshape(b, nc, chunk, g, r, hp)
    dtc = dt.astype(f32).reshape(b, nc, chunk, g, r)
    bc = bmat.astype(f32).reshape(b, nc, chunk, g, n)
    cc = cmat.astype(f32).reshape(b, nc, chunk, g, n)
    cum = jnp.cumsum(dtc * a.astype(f32).reshape(g, r), axis=2)
    tri = jnp.tril(jnp.ones((chunk, chunk), dtype=bool))
    seg = cum[:, :, :, None] - cum[:, :, None, :]
    decay = jnp.exp(jnp.where(tri[:, :, None, None], seg, -jnp.inf))
    cb = jnp.einsum('bcqgn,bcsgn->bcqsg', cc, bc)
    mix = cb[..., None] * decay * dtc[:, :, None]
    y_intra = jnp.einsum('bcqsgr,bcsgrp->bcqgrp', mix, xc)
    w_end = jnp.exp(cum[:, :, -1:] - cum) * dtc
    states = jnp.einsum('bcsgn,bcsgr,bcsgrp->bcgrpn', bc, w_end, xc)
    chunk_decay = jnp.exp(cum[:, :, -1])

    def step(h, inp):
        st, dec = inp
        return dec[..., None, None] * h + st, h

    h_last, h_in = lax.scan(step, h0.astype(f32).reshape(b, g, r, hp, n),
                            (jnp.moveaxis(states, 1, 0), jnp.moveaxis(chunk_decay, 1, 0)))
    h_in = jnp.moveaxis(h_in, 0, 1)
    y_inter = jnp.einsum('bcqgn,bcgrpn,bcqgr->bcqgrp', cc, h_in, jnp.exp(cum))
    return (y_intra + y_inter).reshape(b, length, nh, hp), h_last.reshape(b, nh, hp, n)


def even_mixer(h, ck, cv, clogf, sconv_state, w_in, conv_w, q_gain, k_gain, b_f, w_out):
    b, length, _ = h.shape
    proj = h @ w_in
    cuts = [SC_WIDTH, 2 * SC_WIDTH, 3 * SC_WIDTH, 3 * SC_WIDTH + FOX_WIDTH,
            3 * SC_WIDTH + 2 * FOX_WIDTH, 3 * SC_WIDTH + 3 * FOX_WIDTH]
    gate_b, gate_c, u, q, k, v, f_logit = jnp.split(proj, cuts, axis=-1)
    conv_out, new_sconv = causal_dwconv(gate_c * u, sconv_state, conv_w)
    a_out = gate_b * conv_out
    hs = (b, length, FOX_HEADS, HEAD_DIM)
    q = rms_norm(q.reshape(hs), q_gain)
    k = rms_norm(k.reshape(hs), k_gain)
    v = v.reshape(hs)
    logf = jax.nn.log_sigmoid(f_logit.astype(jnp.float32) + b_f.astype(jnp.float32))
    n_past = ck.shape[1]
    k_all = jnp.concatenate([ck.astype(k.dtype), k], axis=1)
    v_all = jnp.concatenate([cv.astype(v.dtype), v], axis=1)
    logf_all = jnp.concatenate([clogf.astype(jnp.float32), logf], axis=1)
    attn = fox_attention(q, k_all, v_all, logf_all, n_past).reshape(b, length, FOX_WIDTH)
    out = jnp.concatenate([a_out, attn.astype(a_out.dtype)], axis=-1) @ w_out
    return (out, k.astype(ck.dtype), v.astype(cv.dtype), logf.astype(clogf.dtype),
            new_sconv.astype(sconv_state.dtype))


def odd_mixer(h, conv_state, ssm_state, w_in, conv_w, conv_b, dt_bias, a_log, d_skip, norm_w, w_out):
    f32 = jnp.float32
    b, length, _ = h.shape
    proj = h @ w_in
    z, xbc, dt_raw = jnp.split(proj, [D_INNER, D_INNER + CONV_DIM], axis=-1)
    xbc, new_conv = causal_dwconv(xbc, conv_state, conv_w, conv_b)
    xbc = jax.nn.silu(xbc)
    xs, bm, cm = jnp.split(xbc, [D_INNER, D_INNER + SSM_GROUPS * D_STATE], axis=-1)
    dt = jax.nn.softplus(dt_raw.astype(f32) + dt_bias.astype(f32))
    a = -jnp.exp(a_log.astype(f32))
    xs = xs.reshape(b, length, SSM_HEADS, SSM_HEAD_DIM)
    chunk = CHUNK if length % CHUNK == 0 else length
    y, h_last = ssd_scan(xs, dt, a,
                         bm.reshape(b, length, SSM_GROUPS, D_STATE),
                         cm.reshape(b, length, SSM_GROUPS, D_STATE), ssm_state, chunk)
    y = y + d_skip.astype(f32)[:, None] * xs.astype(f32)
    y = y.reshape(b, length, D_INNER) * jax.nn.silu(z.astype(f32))
    y = rms_norm(y.reshape(b, length, SSM_GROUPS, D_INNER // SSM_GROUPS),
                 norm_w.reshape(SSM_GROUPS, D_INNER // SSM_GROUPS)).reshape(b, length, D_INNER)
    out = y.astype(h.dtype) @ w_out
    return out, new_conv.astype(conv_state.dtype), h_last.astype(ssm_state.dtype)


def conv_ffn(h, state, w_up, conv_w, conv_b, w_down):
    a, g = jnp.split(h @ w_up, 2, axis=-1)
    a, new_state = causal_dwconv(a, state, conv_w, conv_b)
    return (jax.nn.silu(a) * g) @ w_down, new_state.astype(state.dtype)


def trunk(x, cache_k, cache_v, cache_logf, st_sconv, st_ssm_conv, st_ssm, st_ffn,
          norm_mix, norm_ffn, w_in_even, conv_a_w, q_norm, k_norm, b_forget, w_out_even,
          w_in_odd, ssm_conv_w, ssm_conv_b, dt_bias, a_log, d_skip, ssm_norm, w_out_odd,
          w_up, ffn_conv_w, ffn_conv_b, w_down):
    nk, nv, nlf, nsc, nsmc, nsm, nff = [], [], [], [], [], [], []
    for i in range(DEPTH):
        j = i // 2
        h = rms_norm(x, norm_mix[i])
        if i % 2 == 0:
            out, k, v, lf, sc = even_mixer(h, cache_k[j], cache_v[j], cache_logf[j], st_sconv[j],
                                           w_in_even[j], conv_a_w[j], q_norm[j], k_norm[j],
                                           b_forget[j], w_out_even[j])
            nk.append(k); nv.append(v); nlf.append(lf); nsc.append(sc)
        else:
            out, cs, ss = odd_mixer(h, st_ssm_conv[j], st_ssm[j], w_in_odd[j], ssm_conv_w[j],
                                    ssm_conv_b[j], dt_bias[j], a_log[j], d_skip[j], ssm_norm[j],
                                    w_out_odd[j])
            nsmc.append(cs); nsm.append(ss)
        x = x + out
        f, fs = conv_ffn(rms_norm(x, norm_ffn[i]), st_ffn[i], w_up[i], ffn_conv_w[i],
                         ffn_conv_b[i], w_down[i])
        nff.append(fs)
        x = x + f
    return (x, jnp.stack(nk), jnp.stack(nv), jnp.stack(nlf), jnp.stack(nsc),
            jnp.stack(nsmc), jnp.stack(nsm), jnp.stack(nff))


def setup_inputs(seed: int = 0) -> dict:
    key = jax.random.key(seed)
    ks = jax.random.split(key, 32)
    f32 = jnp.float32

    def nrm(k, shape, scale):
        return jax.random.normal(k, shape, f32) * scale

    dt0 = jnp.exp(jax.random.uniform(ks[20], (N_ODD, SSM_HEADS), f32,
                                     minval=np.log(1e-3), maxval=np.log(1e-1)))
    return {
        'x_prompt': nrm(ks[0], (BATCH, SEQ, D_MODEL), 1.0),
        'x_sample': nrm(ks[1], (DEC_BATCH, DEC_SEQ, D_MODEL), 1.0),
        'cache_fox_k': nrm(ks[2], (N_EVEN, DEC_BATCH, PAST_LEN, FOX_HEADS, HEAD_DIM), 1.0),
        'cache_fox_v': nrm(ks[3], (N_EVEN, DEC_BATCH, PAST_LEN, FOX_HEADS, HEAD_DIM), 1.0),
        'cache_fox_logf': jax.nn.log_sigmoid(FORGET_BIAS_INIT + nrm(ks[4], (N_EVEN, DEC_BATCH, PAST_LEN, FOX_HEADS), 1.0)),
        'state_sconv': nrm(ks[5], (N_EVEN, DEC_BATCH, SC_CONV - 1, SC_WIDTH), 1.0),
        'state_ssm_conv': nrm(ks[6], (N_ODD, DEC_BATCH, SSM_CONV - 1, CONV_DIM), 1.0),
        'state_ssm': nrm(ks[7], (N_ODD, DEC_BATCH, SSM_HEADS, SSM_HEAD_DIM, D_STATE), 0.1),
        'state_ffn_conv': nrm(ks[8], (DEPTH, DEC_BATCH, FFN_CONV - 1, D_FF), 1.0),
        'norm_mix': 1.0 + nrm(ks[9], (DEPTH, D_MODEL), 0.02),
        'norm_ffn': 1.0 + nrm(ks[10], (DEPTH, D_MODEL), 0.02),
        'w_in_even': nrm(ks[11], (N_EVEN, D_MODEL, EVEN_IN), D_MODEL ** -0.5),
        'conv_a_w': nrm(ks[12], (N_EVEN, SC_CONV, SC_WIDTH), SC_CONV ** -0.5),
        'q_norm': 1.0 + nrm(ks[13], (N_EVEN, HEAD_DIM), 0.02),
        'k_norm': 1.0 + nrm(ks[14], (N_EVEN, HEAD_DIM), 0.02),
        'b_forget': FORGET_BIAS_INIT + nrm(ks[15], (N_EVEN, FOX_HEADS), 0.1),
        'w_out_even': nrm(ks[16], (N_EVEN, SC_WIDTH + FOX_WIDTH, D_MODEL), (SC_WIDTH + FOX_WIDTH) ** -0.5 * RESID_SCALE),
        'w_in_odd': nrm(ks[17], (N_ODD, D_MODEL, ODD_IN), D_MODEL ** -0.5),
        'ssm_conv_w': nrm(ks[18], (N_ODD, SSM_CONV, CONV_DIM), SSM_CONV ** -0.5),
        'ssm_conv_b': nrm(ks[19], (N_ODD, CONV_DIM), 0.02),
        'dt_bias': dt0 + jnp.log(-jnp.expm1(-dt0)),
        'a_log': jnp.log(jax.random.uniform(ks[21], (N_ODD, SSM_HEADS), f32, minval=1.0, maxval=16.0)),
        'd_skip': 1.0 + nrm(ks[22], (N_ODD, SSM_HEADS), 0.1),
        'ssm_norm': 1.0 + nrm(ks[23], (N_ODD, D_INNER), 0.02),
        'w_out_odd': nrm(ks[24], (N_ODD, D_INNER, D_MODEL), D_INNER ** -0.5 * RESID_SCALE),
        'w_up': nrm(ks[25], (DEPTH, D_MODEL, 2 * D_FF), D_MODEL ** -0.5),
        'ffn_conv_w': nrm(ks[26], (DEPTH, FFN_CONV, D_FF), FFN_CONV ** -0.5),
        'ffn_conv_b': nrm(ks[27], (DEPTH, D_FF), 0.02),
        'w_down': nrm(ks[28], (DEPTH, D_FF, D_MODEL), D_FF ** -0.5 * RESID_SCALE),
    }


def reference(x_prompt, x_sample, cache_fox_k, cache_fox_v, cache_fox_logf, state_sconv,
              state_ssm_conv, state_ssm, state_ffn_conv, norm_mix, norm_ffn, w_in_even, conv_a_w,
              q_norm, k_norm, b_forget, w_out_even, w_in_odd, ssm_conv_w, ssm_conv_b, dt_bias,
              a_log, d_skip, ssm_norm, w_out_odd, w_up, ffn_conv_w, ffn_conv_b, w_down):
    bp = x_prompt.shape[0]
    e_k = jnp.zeros((N_EVEN, bp, 0, FOX_HEADS, HEAD_DIM), cache_fox_k.dtype)
    e_v = jnp.zeros((N_EVEN, bp, 0, FOX_HEADS, HEAD_DIM), cache_fox_v.dtype)
    e_lf = jnp.zeros((N_EVEN, bp, 0, FOX_HEADS), cache_fox_logf.dtype)
    z_sc = jnp.zeros((N_EVEN, bp) + state_sconv.shape[2:], state_sconv.dtype)
    z_smc = jnp.zeros((N_ODD, bp) + state_ssm_conv.shape[2:], state_ssm_conv.dtype)
    z_sm = jnp.zeros((N_ODD, bp) + state_ssm.shape[2:], state_ssm.dtype)
    z_ff = jnp.zeros((DEPTH, bp) + state_ffn_conv.shape[2:], state_ffn_conv.dtype)
    y_prompt, p_fox_k, p_fox_v, p_fox_logf, p_sconv, p_ssm_conv, p_ssm, p_ffn_conv = trunk(
        x_prompt, e_k, e_v, e_lf, z_sc, z_smc, z_sm, z_ff,
        norm_mix, norm_ffn, w_in_even, conv_a_w, q_norm, k_norm, b_forget, w_out_even,
        w_in_odd, ssm_conv_w, ssm_conv_b, dt_bias, a_log, d_skip, ssm_norm, w_out_odd,
        w_up, ffn_conv_w, ffn_conv_b, w_down)
    y_sample, s_fox_k, s_fox_v, s_fox_logf, s_sconv, s_ssm_conv, s_ssm, s_ffn_conv = trunk(
        x_sample, cache_fox_k, cache_fox_v, cache_fox_logf, state_sconv, state_ssm_conv,
        state_ssm, state_ffn_conv,
        norm_mix, norm_ffn, w_in_even, conv_a_w, q_norm, k_norm, b_forget, w_out_even,
        w_in_odd, ssm_conv_w, ssm_conv_b, dt_bias, a_log, d_skip, ssm_norm, w_out_odd,
        w_up, ffn_conv_w, ffn_conv_b, w_down)
    return (y_prompt, y_sample, p_fox_k, p_fox_v, p_fox_logf, p_sconv, p_ssm_conv, p_ssm, p_ffn_conv,
            s_fox_k, s_fox_v, s_fox_logf, s_sconv, s_ssm_conv, s_ssm, s_ffn_conv)
```

```cpp
#include <hip/hip_runtime.h>
#include <hip/hip_cooperative_groups.h>
#include <cstdio>
#include <cstdint>
#include <cmath>
namespace cg = cooperative_groups;

#define LAS __attribute__((address_space(3)))
typedef unsigned short bf16_t;
typedef short bf16x8 __attribute__((ext_vector_type(8)));
typedef short s16x4 __attribute__((ext_vector_type(4)));
typedef float f32x4 __attribute__((ext_vector_type(4)));
typedef float f32x2 __attribute__((ext_vector_type(2)));
typedef float f32x16 __attribute__((ext_vector_type(16)));
typedef unsigned u32x4 __attribute__((ext_vector_type(4)));
typedef unsigned u32x2 __attribute__((ext_vector_type(2)));
typedef __bf16 bf16x2_t __attribute__((ext_vector_type(2)));

constexpr int DM = 1024, NBATCH = 32, SEQ = 2048, DBATCH = 8, DSEQ = 16, PAST = 1024;
constexpr int MP = NBATCH * SEQ;
constexpr int MS = DBATCH * DSEQ;
constexpr int MV = MP + MS;
constexpr int MT = 65792;
constexpr int EIN = 3080, EINP = 3328;
constexpr int OIN = 5152, OINP = 5376;
constexpr int FF = 2816, FF2 = 5632;
constexpr int NWAVES = 8, NTHREADS = 512;
constexpr float EPS = 1e-6f;
constexpr float LOG2E = 1.4426950408889634f;
constexpr int KSROWS = 1088;

constexpr size_t O_Y = 0;
constexpr size_t O_PK = (size_t)MV * DM;
constexpr size_t O_PV = O_PK + (size_t)2 * NBATCH * SEQ * 512;
constexpr size_t O_PLF = O_PV + (size_t)2 * NBATCH * SEQ * 512;
constexpr size_t O_PSC = O_PLF + (size_t)2 * NBATCH * SEQ * 8;
constexpr size_t O_PSMC = O_PSC + (size_t)2 * NBATCH * 2 * 512;
constexpr size_t O_PSM = O_PSMC + (size_t)2 * NBATCH * 3 * 3072;
constexpr size_t O_PFF = O_PSM + (size_t)2 * NBATCH * 32 * 64 * 128;
constexpr size_t O_SK = O_PFF + (size_t)4 * NBATCH * 2 * FF;
constexpr size_t O_SV = O_SK + (size_t)2 * DBATCH * DSEQ * 512;
constexpr size_t O_SLF = O_SV + (size_t)2 * DBATCH * DSEQ * 512;
constexpr size_t O_SSC = O_SLF + (size_t)2 * DBATCH * DSEQ * 8;
constexpr size_t O_SSMC = O_SSC + (size_t)2 * DBATCH * 2 * 512;
constexpr size_t O_SSM = O_SSMC + (size_t)2 * DBATCH * 3 * 3072;
constexpr size_t O_SFF = O_SSM + (size_t)2 * DBATCH * 32 * 64 * 128;
constexpr size_t O_END = O_SFF + (size_t)4 * DBATCH * 2 * FF;

constexpr size_t WS_WEIN = 1u << 20;
constexpr size_t WS_WEOUT = WS_WEIN + (size_t)2 * EINP * 1024 * 2;
constexpr size_t WS_WOIN = WS_WEOUT + (size_t)2 * 1024 * 1024 * 2;
constexpr size_t WS_WOOUT = WS_WOIN + (size_t)2 * OINP * 1024 * 2;
constexpr size_t WS_WUP = WS_WOOUT + (size_t)2 * 1024 * 2048 * 2;
constexpr size_t WS_WDN = WS_WUP + (size_t)4 * FF2 * 1024 * 2;
constexpr size_t WS_KS = WS_WDN + (size_t)4 * 1024 * FF * 2;
constexpr size_t WS_VS = WS_KS + (size_t)DBATCH * KSROWS * 512 * 2;
constexpr size_t WS_XN = WS_VS + (size_t)DBATCH * KSROWS * 512 * 2;
constexpr size_t WS_PROJ = WS_XN + (size_t)MT * 1024 * 2;
constexpr size_t WS_SS = WS_PROJ + (size_t)MT * FF2 * 2;
constexpr size_t WS_THA = WS_SS + (size_t)MT * 16 * 4;
constexpr size_t WS_THG = WS_THA + (size_t)257 * 4 * FF * 4;
constexpr size_t WS_RS = WS_THG + (size_t)257 * 2 * FF * 4;
constexpr size_t WS_TMPS = WS_RS + (size_t)MT * 4;
constexpr size_t WS_END = WS_TMPS + (size_t)128 * 2 * FF * 4;
static_assert(WS_END <= (size_t)1073741824, "workspace map exceeds 1 GiB");
static_assert(WS_WEIN % 256 == 0 && WS_XN % 256 == 0 && WS_PROJ % 256 == 0 && WS_KS % 256 == 0, "alignment");

constexpr int LDS_BYTES = 155648;

__device__ __forceinline__ unsigned pk2(float lo, float hi) { f32x2 v = {lo, hi}; bf16x2_t b = __builtin_convertvector(v, bf16x2_t); return __builtin_bit_cast(unsigned, b); }
__device__ __forceinline__ unsigned short f2bf(float f) { return (unsigned short)(pk2(f, 0.f) & 0xffffu); }
__device__ __forceinline__ float bf2f(unsigned short h) { return __uint_as_float(((unsigned)h) << 16); }
__device__ __forceinline__ float bflo(unsigned w) { return __uint_as_float(w << 16); }
__device__ __forceinline__ float bfhi(unsigned w) { return __uint_as_float(w & 0xffff0000u); }
__device__ __forceinline__ float shx(float v, int mask, int lane) { return __builtin_bit_cast(float, __builtin_amdgcn_ds_bpermute((lane ^ mask) << 2, __builtin_bit_cast(int, v))); }
__device__ __forceinline__ float shup(float v, int d, int lane) { return __builtin_bit_cast(float, __builtin_amdgcn_ds_bpermute((lane - d) << 2, __builtin_bit_cast(int, v))); }
template <int N> __device__ __forceinline__ float dpp_shr(float v) { return __builtin_bit_cast(float, __builtin_amdgcn_update_dpp(0, __builtin_bit_cast(int, v), 0x110 + N, 0xF, 0xF, false)); }
__device__ __forceinline__ float wave_sum(float v, int lane) {
#pragma unroll
    for (int o = 1; o < 64; o <<= 1) v += shx(v, o, lane);
    return v;
}
__device__ __forceinline__ float fexp2(float x) { return __builtin_amdgcn_exp2f(x); }
__device__ __forceinline__ float frsq(float x) { return __builtin_amdgcn_rsqf(x); }
__device__ __forceinline__ float fexp(float x) { return __builtin_amdgcn_exp2f(x * LOG2E); }
__device__ __forceinline__ float sigmoidf_(float x) { return __builtin_amdgcn_rcpf(1.f + fexp(-x)); }
__device__ __forceinline__ float siluf_(float x) { return x * sigmoidf_(x); }
__device__ __forceinline__ float log1pexp_neg(float ax) { return 0.6931471805599453f * __builtin_amdgcn_logf(1.f + fexp(-ax)); }
__device__ __forceinline__ float softplusf_(float x) { return fmaxf(x, 0.f) + log1pexp_neg(fabsf(x)); }
__device__ __forceinline__ int crow(int r, int hi) { return (r & 3) + 8 * (r >> 2) + 4 * hi; }
#define LDS_WAIT() asm volatile("s_waitcnt lgkmcnt(0)" ::: "memory")
__device__ __forceinline__ const float* argp(int i) {
    typedef const float* fptr;
    const __attribute__((address_space(4))) fptr* kp = (const __attribute__((address_space(4))) fptr*)__builtin_amdgcn_kernarg_segment_ptr();
    asm volatile("" : "+s"(kp));
    return kp[i];
}
#define ARG_OUT ((float*)argp(29))
#define ARG_WS ((unsigned char*)argp(30))
__device__ __forceinline__ int fresh_lane() { int l = (int)__builtin_amdgcn_mbcnt_hi(~0u, __builtin_amdgcn_mbcnt_lo(~0u, 0u)); asm volatile("" : "+v"(l)); return l; }
__device__ __forceinline__ int ltid(int wv0) { int t = wv0 * 64 + (int)__builtin_amdgcn_mbcnt_hi(~0u, __builtin_amdgcn_mbcnt_lo(~0u, 0u)); asm volatile("" : "+v"(t)); return t; }

namespace pg8 {
constexpr int BM = 256, BK = 64, HALF = 128, HTB = HALF * BK * 2, STAGE_BYTES = 8 * HTB, NXCD = 8, WGM = 8;
__host__ __device__ __forceinline__ int lds_byte(int r, int c) { const int st = (r >> 4) * 2 + (c >> 5), rr = r & 15, cc = c & 31, ob = rr * 64 + cc * 2; return st * 1024 + (ob ^ (((ob >> 9) & 1) << 5)); }
__host__ __device__ __forceinline__ void stage_rc(int b, int& R, int& C) { const int st = b / 1024, sb = b % 1024, swz = sb ^ (((sb >> 9) & 1) << 5); R = (st >> 1) * 16 + swz / 64; C = (st & 1) * 32 + (swz % 64) / 2; }
__host__ __device__ __forceinline__ int perm32(int rho) { const int n = rho >> 4, i = rho & 15; return 8 * (i >> 2) + 4 * n + (i & 3); }
struct Unit { int pm, pn, kt0, nkt; };
struct Gemm { const bf16_t* A; const bf16_t* Bt; int lda, K, M, N; };
struct StaticOrder {
    int nM, nN, nmain, G, c, ntf, nsplit, ktc;
    __host__ __device__ void init(int Mmain, int N, int K, int G_, int c_, int ktc_) { nM = Mmain / BM; nN = N / BM; nmain = nM * nN; G = G_; c = c_; ntf = K / BK; ktc = ktc_ ? ktc_ : ntf; nsplit = (ntf + ktc - 1) / ktc; }
    __host__ __device__ bool next(int i, Unit& u) const {
        const long L = (long)i * G + c;
        if (L >= nmain) { const int s = (int)(L - nmain); if (s >= nN * nsplit) return false;
            u.pm = nM;
            if (nsplit == 1) { u.pn = s; u.kt0 = 0; u.nkt = ntf; }
            else { u.pn = s & 3; u.kt0 = (s >> 2) * ktc; u.nkt = (ntf - u.kt0) < ktc ? (ntf - u.kt0) : ktc; }
            return true; }
        int wgid = (int)L; { const int q = nmain / NXCD, r = nmain % NXCD, xcd = wgid % NXCD, off = wgid / NXCD; wgid = (xcd < r ? xcd * (q + 1) : r * (q + 1) + (xcd - r) * q) + off; }
        const int nig = WGM * nN, gid = wgid / nig, fm = gid * WGM, gsz = (nM - fm) < WGM ? (nM - fm) : WGM;
        u.pm = fm + ((wgid % nig) % gsz); u.pn = (wgid % nig) / gsz; u.kt0 = 0; u.nkt = ntf; return true;
    }
};
struct EpiStoreBf16 {
    static constexpr bool PERM = true;
    bf16_t* O; int ldc; const float* SS;
    __device__ __forceinline__ void operator()(const f32x4 (&acc)[2][2][4][2], const Unit& u, int wr, int wc, int, int, LAS unsigned char*) const {
        const int ln_ = fresh_lane(), fr = ln_ & 15, fq = ln_ >> 4;
        const int row0 = u.pm * BM + wr * 64 + fr; const int col0 = u.pn * BM + wc * 32 + 8 * fq;
        float rsv[2][4];
#pragma unroll
        for (int ai = 0; ai < 2; ++ai)
#pragma unroll
            for (int m = 0; m < 4; ++m) rsv[ai][m] = SS[row0 + ai * HALF + m * 16];
#pragma unroll
        for (int ai = 0; ai < 2; ++ai)
#pragma unroll
            for (int m = 0; m < 4; ++m) { bf16_t* rowp = O + (size_t)(row0 + ai * HALF + m * 16) * ldc + col0;
                const float rs = rsv[ai][m];
#pragma unroll
                for (int bj = 0; bj < 2; ++bj) { const f32x4 v0 = acc[ai][bj][m][0] * rs, v1 = acc[ai][bj][m][1] * rs;
                    u32x4 w; w.x = pk2(v0[0], v0[1]); w.y = pk2(v0[2], v0[3]); w.z = pk2(v1[0], v1[1]); w.w = pk2(v1[2], v1[3]);
                    *(u32x4*)(rowp + bj * HALF) = w; } }
    }
};
struct EpiResid {
    static constexpr bool PERM = false;
    float* X; bf16_t* XB; float* SSn; int mvalid, ntfull; bool final_f32;
    __device__ __forceinline__ void operator()(const f32x4 (&acc)[2][2][4][2], const Unit& u, int wr, int wc, int, int, LAS unsigned char*) const {
        const int ln_ = fresh_lane(), fr = ln_ & 15, fq = ln_ >> 4;
        const int col0 = u.pn * BM + wc * 32 + 4 * fq;
        if (u.nkt != ntfull) {
#pragma unroll
            for (int m = 0; m < 4; ++m) { const int row = u.pm * BM + wr * 64 + m * 16 + fr;
                if (row < mvalid) { float* rp = X + (size_t)row * DM + col0;
#pragma unroll
                    for (int bj = 0; bj < 2; ++bj)
#pragma unroll
                        for (int n = 0; n < 2; ++n) { float* p = rp + bj * HALF + n * 16; const f32x4 v = acc[0][bj][m][n];
                            unsafeAtomicAdd(p, v.x); unsafeAtomicAdd(p + 1, v.y); unsafeAtomicAdd(p + 2, v.z); unsafeAtomicAdd(p + 3, v.w); } } }
            return;
        }
#pragma unroll
        for (int ai = 0; ai < 2; ++ai) {
            u32x2 xv[4][2][2];
#pragma unroll
            for (int m = 0; m < 4; ++m) { const bf16_t* bp = XB + (size_t)(u.pm * BM + ai * HALF + wr * 64 + m * 16 + fr) * DM + col0;
#pragma unroll
                for (int bj = 0; bj < 2; ++bj)
#pragma unroll
                    for (int n = 0; n < 2; ++n) xv[m][bj][n] = *(const u32x2*)(bp + bj * HALF + n * 16); }
#pragma unroll
            for (int m = 0; m < 4; ++m) { const int row = u.pm * BM + ai * HALF + wr * 64 + m * 16 + fr;
                float ss = 0.f;
                float* rp = X + (size_t)row * DM + col0; bf16_t* bp = XB + (size_t)row * DM + col0;
#pragma unroll
                for (int bj = 0; bj < 2; ++bj)
#pragma unroll
                    for (int n = 0; n < 2; ++n) { const u32x2 xw = xv[m][bj][n];
                        const f32x4 v = (f32x4){bflo(xw.x), bfhi(xw.x), bflo(xw.y), bfhi(xw.y)} + acc[ai][bj][m][n];
                        if (final_f32) *(f32x4*)(rp + bj * HALF + n * 16) = v;
                        else { ss += (v.x * v.x + v.y * v.y) + (v.z * v.z + v.w * v.w);
                            u32x2 w; w.x = pk2(v.x, v.y); w.y = pk2(v.z, v.w); *(u32x2*)(bp + bj * HALF + n * 16) = w; } }
                if (!final_f32) { const int ln = fr + 16 * fq; ss += shx(ss, 16, ln); ss += shx(ss, 32, ln);
                    if (fq == 0) SSn[(size_t)row * 16 + u.pn * 4 + wc] = ss; } }
        }
    }
};

struct EpiFfnUp {
    static constexpr bool PERM = true;
    int layer;
    __device__ __forceinline__ void operator()(f32x4 (&acc)[2][2][4][2], const Unit& u, int wr, int wc, int, int, LAS unsigned char* lds) const {
        const int ln_ = fresh_lane(), fr = ln_ & 15, fq = ln_ >> 4;
        unsigned char* ws_ = ARG_WS;
        const float* SS = (const float*)(ws_ + WS_RS);
        const int chl = wc * 32 + 8 * fq;
        const int ch0 = u.pn * 128 + chl;
        float rsv[2][4];
#pragma unroll
        for (int ai = 0; ai < 2; ++ai)
#pragma unroll
            for (int m = 0; m < 4; ++m) rsv[ai][m] = SS[u.pm * BM + ai * HALF + wr * 64 + m * 16 + fr];
        if (u.pm == 256) {
            float* T = (float*)(ws_ + WS_TMPS);
#pragma unroll
            for (int m = 0; m < 4; ++m) { float* tp = T + (size_t)(wr * 64 + m * 16 + fr) * (2 * FF) + ch0; const float rs = rsv[0][m];
#pragma unroll
                for (int n = 0; n < 2; ++n) { *(f32x4*)(tp + 4 * n) = acc[0][0][m][n] * rs; *(f32x4*)(tp + FF + 4 * n) = acc[0][1][m][n] * rs; } }
            return;
        }
        LAS float* halo = (LAS float*)(lds + STAGE_BYTES);
        bf16_t* H = (bf16_t*)(ws_ + WS_PROJ); float* THA = (float*)(ws_ + WS_THA); float* THG = (float*)(ws_ + WS_THG);
        const float* cw = argp(26); const float* cb = argp(27); float* out_p = ARG_OUT + O_PFF;
#pragma unroll
        for (int ai = 0; ai < 2; ++ai)
#pragma unroll
            for (int m = 0; m < 4; ++m) { const float rs = rsv[ai][m];
                acc[ai][0][m][0] *= rs; acc[ai][0][m][1] *= rs; acc[ai][1][m][0] *= rs; acc[ai][1][m][1] *= rs; }
        if (fr >= 14) {
#pragma unroll
            for (int ai = 0; ai < 2; ++ai)
#pragma unroll
                for (int m = 0; m < 4; ++m) { const int bi = 8 * ai + 4 * wr + m; int fo = 0; asm volatile("" : "+v"(fo) :: "memory");
#pragma unroll
                    for (int n = 0; n < 2; ++n) *(LAS f32x4*)(halo + fo + (bi * 2 + (fr - 14)) * 128 + chl + 4 * n) = acc[ai][0][m][n]; }
        }
        asm volatile("s_waitcnt lgkmcnt(0)\n\ts_barrier" ::: "memory");
        const bool seqstart = (u.pm & 7) == 0;
#pragma unroll
        for (int n = 0; n < 2; ++n) {
            asm volatile("" ::: "memory");
            const float* wp = cw + (size_t)layer * 3 * FF + ch0 + 4 * n;
            const f32x4 w0 = *(const f32x4*)wp, w1 = *(const f32x4*)(wp + FF), w2 = *(const f32x4*)(wp + 2 * FF), bb = *(const f32x4*)(cb + (size_t)layer * FF + ch0 + 4 * n);
            asm volatile("" :: "v"(w0), "v"(w1), "v"(w2), "v"(bb));
#pragma unroll
            for (int ai = 0; ai < 2; ++ai)
#pragma unroll
                for (int m = 0; m < 4; ++m) {
                    int fo = 0; asm volatile("" : "+v"(fo) :: "memory");
                    const int bi = 8 * ai + 4 * wr + m, rl = 16 * bi + fr + fo, row = u.pm * BM + rl;
                    const f32x4 cur = acc[ai][0][m][n], gv = acc[ai][1][m][n];
                    f32x4 p1, p2;
                    p1.x = dpp_shr<1>(cur.x); p1.y = dpp_shr<1>(cur.y); p1.z = dpp_shr<1>(cur.z); p1.w = dpp_shr<1>(cur.w);
                    p2.x = dpp_shr<2>(cur.x); p2.y = dpp_shr<2>(cur.y); p2.z = dpp_shr<2>(cur.z); p2.w = dpp_shr<2>(cur.w);
                    bool defer = false;
                    if (fr < 2) {
                        f32x4 e1 = (f32x4){0.f, 0.f, 0.f, 0.f}, e2 = e1;
                        if (bi > 0) { LAS float* hp = halo + fo + chl + 4 * n; e2 = *(LAS f32x4*)(hp + ((bi - 1) * 2 + 0) * 128); e1 = *(LAS f32x4*)(hp + ((bi - 1) * 2 + 1) * 128); }
                        else defer = !seqstart;
                        if (fr == 0) { p1 = e1; p2 = e2; } else { p2 = e1; }
                        if (defer) { *(f32x4*)(THA + ((size_t)u.pm * 4 + 2 + fr) * FF + ch0 + 4 * n) = cur; *(f32x4*)(THG + ((size_t)u.pm * 2 + fr) * FF + ch0 + 4 * n) = gv; }
                    }
                    if (fr >= 14 && bi == 15) {
                        *(f32x4*)(THA + ((size_t)u.pm * 4 + (fr - 14)) * FF + ch0 + 4 * n) = cur;
                        if ((u.pm & 7) == 7) *(f32x4*)(out_p + ((size_t)(layer * NBATCH + (u.pm >> 3)) * 2 + (fr - 14)) * FF + ch0 + 4 * n) = cur;
                    }
                    const f32x4 y = bb + w0 * p2 + w1 * p1 + w2 * cur;
                    u32x2 hw; hw.x = pk2(siluf_(y.x) * gv.x, siluf_(y.y) * gv.y); hw.y = pk2(siluf_(y.z) * gv.z, siluf_(y.w) * gv.w);
                    if (!defer) *(u32x2*)(H + (size_t)row * FF + ch0 + 4 * n) = hw;
                }
        }
    }
};

template <class Epi>
__device__ __forceinline__ void gemm_phase(LAS unsigned char* lds, const Gemm g, const StaticOrder& S, const Epi& E, int wv0) {
    const int tid = ltid(wv0), wid = __builtin_amdgcn_readfirstlane(tid >> 6), lane = tid & 63, wr = wid >> 2, wc = wid & 3, fr = lane & 15, fq = lane >> 4;
    const int K = g.K, lda = g.lda;
    unsigned voffA[2], voffB[2];
#pragma unroll
    for (int i = 0; i < 2; ++i) { int R, C; stage_rc(tid * 16 + i * 8192, R, C); const int Rb = Epi::PERM ? ((R & ~31) + perm32(R & 31)) : R;
        voffA[i] = (unsigned)(R * lda + C) * 2u; voffB[i] = (unsigned)(Rb * K + C) * 2u; }
    constexpr unsigned kstep = BK * 2;
    const unsigned hsA = (unsigned)HALF * lda * 2u, hsB = (unsigned)HALF * K * 2u;
    const unsigned tsA = 2u * hsA, tsB = 2u * hsB;
    const unsigned ldsw = (unsigned)wid * 1024u;
    const int aoff = lds_byte(wr * 64 + fr, fq * 8), boff = lds_byte(wc * 32 + fr, fq * 8);
#define PG8_SA(b, h) (((b) * 2 + (h)) * HTB)
#define PG8_SB(b, h) ((4 + (b) * 2 + (h)) * HTB)
#define PG8_STAGE(bufoff, gbase, voff) do { _Pragma("unroll") for (int _i = 0; _i < 2; ++_i) \
        __builtin_amdgcn_global_load_lds((const unsigned*)((const char*)(gbase) + (voff)[_i]), (LAS unsigned*)(lds + (bufoff) + ldsw + _i * 8192), 16, 0, 0); } while (0)
#define PG8_LDA(dst, b, h) do { _Pragma("unroll") for (int m = 0; m < 4; ++m) _Pragma("unroll") for (int k = 0; k < 2; ++k) dst[m][k] = *(const LAS bf16x8*)(lds + PG8_SA(b, h) + aoff + m * 2048 + k * 1024); } while (0)
#define PG8_LDB(dst, b, h) do { _Pragma("unroll") for (int n = 0; n < 2; ++n) _Pragma("unroll") for (int k = 0; k < 2; ++k) dst[n][k] = *(const LAS bf16x8*)(lds + PG8_SB(b, h) + boff + n * 2048 + k * 1024); } while (0)
#define PG8_MMA(ai, bj, At, Bt) do { __builtin_amdgcn_s_setprio(1); _Pragma("unroll") for (int m = 0; m < 4; ++m) _Pragma("unroll") for (int n = 0; n < 2; ++n) _Pragma("unroll") for (int k = 0; k < 2; ++k) \
        acc[ai][bj][m][n] = __builtin_amdgcn_mfma_f32_16x16x32_bf16(Bt[n][k], At[m][k], acc[ai][bj][m][n], 0, 0, 0); __builtin_amdgcn_s_setprio(0); } while (0)
#define PG8_WAIT_V(n) asm volatile("s_waitcnt vmcnt(" #n ")" ::: "memory")
#define PG8_WAIT_L(n) asm volatile("s_waitcnt lgkmcnt(" #n ")" ::: "memory")
#define PG8_BAR __builtin_amdgcn_s_barrier()
#define PG8_SCHED __builtin_amdgcn_sched_barrier(0)
    Unit cur, nxt; int ui = 0;
    if (!S.next(0, cur)) return;
    f32x4 acc[2][2][4][2];
#pragma unroll
    for (int a = 0; a < 2; ++a)
#pragma unroll
        for (int b = 0; b < 2; ++b)
#pragma unroll
            for (int m = 0; m < 4; ++m)
#pragma unroll
                for (int n = 0; n < 2; ++n) acc[a][b][m][n] = (f32x4){0.f, 0.f, 0.f, 0.f};
    bf16x8 At[4][2], B0[2][2], B1[2][2];
    const char* cA = (const char*)g.A + ((unsigned)cur.pm * tsA + (unsigned)cur.kt0 * kstep); const char* cB = (const char*)g.Bt + ((unsigned)cur.pn * tsB + (unsigned)cur.kt0 * kstep);
    PG8_STAGE(PG8_SB(0, 0), cB, voffB); PG8_STAGE(PG8_SB(0, 1), cB + hsB, voffB); PG8_STAGE(PG8_SA(0, 0), cA, voffA); PG8_STAGE(PG8_SA(0, 1), cA + hsA, voffA);
    if (wr == 1) PG8_BAR;
    PG8_WAIT_V(2); PG8_BAR;
    PG8_STAGE(PG8_SB(1, 0), cB + kstep, voffB); PG8_STAGE(PG8_SA(1, 0), cA + kstep, voffA); PG8_STAGE(PG8_SB(1, 1), cB + hsB + kstep, voffB);
    PG8_WAIT_V(6); PG8_BAR;
    for (;;) {
        const bool has_next = S.next(ui + 1, nxt);
        const char* nA = has_next ? (const char*)g.A + ((unsigned)nxt.pm * tsA + (unsigned)nxt.kt0 * kstep) : cA; const char* nB = has_next ? (const char*)g.Bt + ((unsigned)nxt.pn * tsB + (unsigned)nxt.kt0 * kstep) : cB;
        const int nt = cur.nkt;
        for (int t = 0; t < nt; t += 2) {
            const bool last = (t == nt - 2);
            const char* a1 = cA + (unsigned)(t + 1) * kstep;
            const char* a2 = last ? nA : cA + (unsigned)(t + 2) * kstep; const char* b2 = last ? nB : cB + (unsigned)(t + 2) * kstep;
            const char* a3 = a2 + kstep; const char* b3 = b2 + kstep;
            PG8_LDB(B0, 0, 0); PG8_LDB(B1, 0, 1); PG8_SCHED; PG8_LDA(At, 0, 0); PG8_STAGE(PG8_SA(1, 1), a1 + hsA, voffA);
            PG8_WAIT_V(8); PG8_WAIT_L(0); PG8_BAR; PG8_MMA(0, 0, At, B0); PG8_MMA(0, 1, At, B1); PG8_BAR; PG8_SCHED;
            PG8_LDA(At, 0, 1); PG8_STAGE(PG8_SB(0, 0), b2, voffB); PG8_STAGE(PG8_SB(0, 1), b2 + hsB, voffB); PG8_STAGE(PG8_SA(0, 0), a2, voffA);
            PG8_WAIT_V(8); PG8_WAIT_L(0); PG8_BAR; PG8_MMA(1, 0, At, B0); PG8_MMA(1, 1, At, B1); PG8_BAR; PG8_SCHED;
            PG8_LDB(B0, 1, 0); PG8_LDB(B1, 1, 1); PG8_SCHED; PG8_LDA(At, 1, 0); PG8_STAGE(PG8_SA(0, 1), a2 + hsA, voffA);
            PG8_WAIT_V(8); PG8_WAIT_L(0); PG8_BAR; PG8_MMA(0, 0, At, B0); PG8_MMA(0, 1, At, B1); PG8_BAR; PG8_SCHED;
            PG8_LDA(At, 1, 1); PG8_STAGE(PG8_SB(1, 0), b3, voffB); PG8_STAGE(PG8_SB(1, 1), b3 + hsB, voffB); PG8_STAGE(PG8_SA(1, 0), a3, voffA);
            PG8_WAIT_V(8); PG8_WAIT_L(0); PG8_BAR; PG8_MMA(1, 0, At, B0); PG8_MMA(1, 1, At, B1); PG8_BAR; PG8_SCHED;
        }
        if (wr == 0) PG8_BAR;
        E(acc, cur, wr, wc, fr, fq, lds);
        if (!has_next) break;
#pragma unroll
        for (int a = 0; a < 2; ++a)
#pragma unroll
            for (int b = 0; b < 2; ++b)
#pragma unroll
                for (int m = 0; m < 4; ++m)
#pragma unroll
                    for (int n = 0; n < 2; ++n) acc[a][b][m][n] = (f32x4){0.f, 0.f, 0.f, 0.f};
        cur = nxt; cA = nA; cB = nB; ++ui;
        if (wr == 1) PG8_BAR;
    }
    PG8_WAIT_V(0);
    PG8_BAR;
#undef PG8_SA
#undef PG8_SB
#undef PG8_STAGE
#undef PG8_LDA
#undef PG8_LDB
#undef PG8_MMA
#undef PG8_WAIT_V
#undef PG8_WAIT_L
#undef PG8_BAR
#undef PG8_SCHED
}
}

__device__ __forceinline__ void transpose_item(const float* W, int K, int N, int Nvalid, bf16_t* WT, int kb, int nb, int evenperm, const float* gain, LAS float* scr, int lane) {
    const int k0 = 64 * kb, n0 = 32 * nb;
    int ns0 = n0;
    if (evenperm == 1) { if (n0 < 512) ns0 = n0 + 1024; else if (n0 >= 1024 && n0 < 1536) ns0 = n0 - 1024; }
    else if (evenperm == 2) { const int blk = n0 >> 8, r = n0 & 255; ns0 = (r < 128) ? 128 * blk + r : FF + 128 * blk + (r - 128); }
    const int nn = lane & 31; const bool ok = (n0 + nn) < Nvalid;
#pragma unroll 8
    for (int i = 0; i < 32; ++i) { const int kk = 2 * i + (lane >> 5); const float gk = gain ? gain[k0 + kk] : 1.f; scr[kk * 33 + nn] = ok ? W[(size_t)(k0 + kk) * N + ns0 + nn] * gk : 0.f; }
    LDS_WAIT(); asm volatile("" ::: "memory");
    const int c = lane & 7;
#pragma unroll
    for (int j = 0; j < 4; ++j) { const int n = (lane >> 3) + 8 * j; const LAS float* s = scr + (8 * c) * 33 + n;
        u32x4 o; o.x = pk2(s[0 * 33], s[1 * 33]); o.y = pk2(s[2 * 33], s[3 * 33]); o.z = pk2(s[4 * 33], s[5 * 33]); o.w = pk2(s[6 * 33], s[7 * 33]);
        *(u32x4*)(WT + (size_t)(n0 + n) * K + k0 + 8 * c) = o; }
    LDS_WAIT(); asm volatile("" ::: "memory");
}

__device__ __forceinline__ bool transpose_family(int& it, const float* src, bf16_t* dst, int nl, int K, int N, int Npad, int evenperm, const float* gain, int gstride, int goff, LAS float* scr, int lane) {
    const int nblk = Npad / 32, per = (K / 64) * nblk, tot = nl * per;
    if (it >= tot) { it -= tot; return false; }
    const int l = it / per, r = it % per;
    transpose_item(src + (size_t)l * K * N, K, N, N, dst + (size_t)l * Npad * K, r / nblk, r % nblk, evenperm, gain ? gain + (size_t)(l * gstride + goff) * DM : nullptr, scr, lane);
    return true;
}

__device__ __forceinline__ void cast_row(const float* xrow, bf16_t* orow, float* copyrow, float* ssp, int lane) {
    const f32x4* xr = (const f32x4*)xrow + lane;
    f32x4 v[4]; float s = 0.f;
#pragma unroll
    for (int j = 0; j < 4; ++j) { v[j] = xr[64 * j]; s += (v[j].x * v[j].x + v[j].y * v[j].y) + (v[j].z * v[j].z + v[j].w * v[j].w); }
    s = wave_sum(s, lane);
    unsigned long long* o8 = (unsigned long long*)orow + lane;
#pragma unroll
    for (int j = 0; j < 4; ++j) {
        o8[64 * j] = (unsigned long long)pk2(v[j].x, v[j].y) | ((unsigned long long)pk2(v[j].z, v[j].w) << 32);
        if (copyrow) ((f32x4*)copyrow + lane)[64 * j] = v[j];
    }
    if (lane == 0) *ssp = frsq((s + EPS * DM) * (1.f / DM));
}

__device__ __forceinline__ void unpack8(const u32x4 w, float (&f)[8]) {
    f[0] = bflo(w.x); f[1] = bfhi(w.x); f[2] = bflo(w.y); f[3] = bfhi(w.y); f[4] = bflo(w.z); f[5] = bfhi(w.z); f[6] = bflo(w.w); f[7] = bfhi(w.w);
}
__device__ __forceinline__ u32x4 pack8(const float (&f)[8]) { u32x4 w; w.x = pk2(f[0], f[1]); w.y = pk2(f[2], f[3]); w.z = pk2(f[4], f[5]); w.w = pk2(f[6], f[7]); return w; }

__device__ __forceinline__ void even_prep_row(int m, int j, bf16_t* PROJ, float* out, const float* state_sconv, const float* conv_w, const float* qg, const float* kg, const float* bfg,
                                              bf16_t* KS, bf16_t* VS, int lane) {
    int b, t, L; bool isS;
    if (m < MP) { b = m >> 11; t = m & 2047; L = SEQ; isS = false; } else { const int mm = m - MP; b = mm >> 4; t = mm & 15; L = DSEQ; isS = true; }
    bf16_t* P = PROJ + (size_t)m * EINP;
    const int c0 = lane * 8;
    const u32x4 gbw = *(const u32x4*)(P + 1024 + c0), qw = *(const u32x4*)(P + 1536 + c0), kw = *(const u32x4*)(P + 2048 + c0), vw = *(const u32x4*)(P + 2560 + c0);
    const unsigned short fw = (lane < 8) ? P[3072 + lane] : (unsigned short)0;
    float cu[3][8];
#pragma unroll
    for (int d = 0; d < 3; ++d) {
        const int tau = t - 2 + d;
        if (tau >= 0) {
            const bf16_t* Pr = PROJ + (size_t)(m - 2 + d) * EINP;
            float u[8], gc[8]; unpack8(*(const u32x4*)(Pr + c0), u); unpack8(*(const u32x4*)(Pr + 512 + c0), gc);
#pragma unroll
            for (int e = 0; e < 8; ++e) cu[d][e] = gc[e] * u[e];
        } else if (isS) {
            const float* sp = state_sconv + ((size_t)(j * DBATCH + b) * 2 + (tau + 2)) * 512 + c0;
            const f32x4 a = *(const f32x4*)sp, c = *(const f32x4*)(sp + 4);
            cu[d][0] = a.x; cu[d][1] = a.y; cu[d][2] = a.z; cu[d][3] = a.w; cu[d][4] = c.x; cu[d][5] = c.y; cu[d][6] = c.z; cu[d][7] = c.w;
        } else {
#pragma unroll
            for (int e = 0; e < 8; ++e) cu[d][e] = 0.f;
        }
    }
    {
        float gb[8]; unpack8(gbw, gb);
        const float* w = conv_w + (size_t)j * 3 * 512 + c0;
        float o[8];
#pragma unroll
        for (int e = 0; e < 8; ++e) o[e] = gb[e] * (w[e] * cu[0][e] + w[512 + e] * cu[1][e] + w[1024 + e] * cu[2][e]);
        *(u32x4*)(P + 1024 + c0) = pack8(o);
        if (t >= L - 2) {
            float* sp = out + (isS ? O_SSC + ((size_t)(j * DBATCH + b) * 2 + (t - (L - 2))) * 512 : O_PSC + ((size_t)(j * NBATCH + b) * 2 + (t - (L - 2))) * 512) + c0;
            *(f32x4*)sp = (f32x4){cu[2][0], cu[2][1], cu[2][2], cu[2][3]}; *(f32x4*)(sp + 4) = (f32x4){cu[2][4], cu[2][5], cu[2][6], cu[2][7]};
        }
    }
    const int d0 = (lane & 7) * 8;
    {
        float q[8]; unpack8(qw, q);
        float ss = 0.f;
#pragma unroll
        for (int e = 0; e < 8; ++e) ss += q[e] * q[e];
        ss += shx(ss, 1, lane); ss += shx(ss, 2, lane); ss += shx(ss, 4, lane);
        const float r = frsq((ss + EPS * 64.f) * (1.f / 64.f)) * (0.125f * LOG2E);
        const float* gq = qg + j * 64 + d0;
#pragma unroll
        for (int e = 0; e < 8; ++e) q[e] = q[e] * r * gq[e];
        *(u32x4*)(P + 1536 + c0) = pack8(q);
    }
    {
        float k[8]; unpack8(kw, k);
        float ss = 0.f;
#pragma unroll
        for (int e = 0; e < 8; ++e) ss += k[e] * k[e];
        ss += shx(ss, 1, lane); ss += shx(ss, 2, lane); ss += shx(ss, 4, lane);
        const float r = frsq((ss + EPS * 64.f) * (1.f / 64.f));
        const float* gk = kg + j * 64 + d0;
#pragma unroll
        for (int e = 0; e < 8; ++e) k[e] = k[e] * r * gk[e];
        const u32x4 kb = pack8(k);
        *(u32x4*)(P + 2048 + c0) = kb;
        float* op = out + (isS ? O_SK + ((size_t)(j * DBATCH + b) * DSEQ + t) * 512 : O_PK + ((size_t)(j * NBATCH + b) * SEQ + t) * 512) + c0;
        *(f32x4*)op = (f32x4){k[0], k[1], k[2], k[3]}; *(f32x4*)(op + 4) = (f32x4){k[4], k[5], k[6], k[7]};
        if (isS) *(u32x4*)(KS + ((size_t)b * KSROWS + PAST + t) * 512 + c0) = kb;
    }
    {
        const u32x4 vb = vw;
        float v[8]; unpack8(vb, v);
        float* op = out + (isS ? O_SV + ((size_t)(j * DBATCH + b) * DSEQ + t) * 512 : O_PV + ((size_t)(j * NBATCH + b) * SEQ + t) * 512) + c0;
        *(f32x4*)op = (f32x4){v[0], v[1], v[2], v[3]}; *(f32x4*)(op + 4) = (f32x4){v[4], v[5], v[6], v[7]};
        if (isS) *(u32x4*)(VS + ((size_t)b * KSROWS + PAST + t) * 512 + c0) = vb;
    }
    if (lane < 8) {
        const float f = bf2f(fw) + bfg[j * 8 + lane];
        const float lf = fminf(f, 0.f) - log1pexp_neg(fabsf(f));
        out[(isS ? O_SLF + ((size_t)(j * DBATCH + b) * DSEQ + t) * 8 : O_PLF + ((size_t)(j * NBATCH + b) * SEQ + t) * 8) + lane] = lf;
    }
}

constexpr int AT_KB = 9216, AT_VB = 8192;
constexpr int AT_K0 = 0, AT_V0 = 2 * AT_KB, AT_CUM = AT_V0 + 2 * AT_VB, AT_WS = AT_CUM + 2112 * 4, AT_END = AT_WS + 64;
__device__ __forceinline__ s16x4 vtr(LAS unsigned char* p) { typedef short v4i16_t __attribute__((ext_vector_type(4))); return __builtin_bit_cast(s16x4, __builtin_amdgcn_ds_read_tr16_b64_v4i16((LAS v4i16_t*)p)); }

__device__ __forceinline__ void attn_unit(LAS unsigned char* lds, bf16_t* Q, int qpitch, const bf16_t* K, const bf16_t* V, int kvpitch, int nq, int qpos0, int nkeys,
                                          const float* lf_past, int npast, const float* lf_new, int nact, int wv0, bool reuse_cum) {
    const int tid = ltid(wv0), lane = tid & 63, wave = __builtin_amdgcn_readfirstlane(tid >> 6), r32 = lane & 31, hi = lane >> 5;
    const int NT = (nkeys + 63) >> 6;
    LAS float* cum2 = (LAS float*)(lds + AT_CUM); LAS float* wsum = (LAS float*)(lds + AT_WS);
    __syncthreads();
    if (!reuse_cum) {
        float v[4];
#pragma unroll
        for (int e = 0; e < 4; ++e) { const int i = 4 * tid + e; v[e] = (i < nkeys) ? (i < npast ? lf_past[(size_t)i * 8] : lf_new[(size_t)(i - npast) * 8]) : 0.f; }
        v[1] += v[0]; v[2] += v[1]; v[3] += v[2];
        const float tot = v[3]; float sc = tot;
#pragma unroll
        for (int o = 1; o < 64; o <<= 1) { const float tt = shup(sc, o, lane); if (lane >= o) sc += tt; }
        if (lane == 63) wsum[wave] = sc;
        __syncthreads();
        float woff = 0.f;
        for (int w = 0; w < wave; ++w) woff += wsum[w];
        const float base = woff + sc - tot;
        *(LAS f32x4*)(cum2 + 4 * tid) = (f32x4){(base + v[0]) * -LOG2E, (base + v[1]) * -LOG2E, (base + v[2]) * -LOG2E, (base + v[3]) * -LOG2E};
    }
    const int srow = tid >> 3, sch = tid & 7;
    const bf16_t* kg = K + (size_t)srow * kvpitch + sch * 8; const bf16_t* vg = V + (size_t)srow * kvpitch + sch * 8;
    const int kdst = srow * 144 + sch * 16, vdst = (sch >> 2) * 4096 + srow * 64 + (sch & 3) * 16;
    u32x4 kreg = *(const u32x4*)(kg + (size_t)(NT - 1) * 64 * kvpitch), vreg = *(const u32x4*)(vg + (size_t)(NT - 1) * 64 * kvpitch);
    *(LAS u32x4*)(lds + AT_K0 + kdst) = kreg; *(LAS u32x4*)(lds + AT_V0 + vdst) = vreg;
    if (NT > 1) { kreg = *(const u32x4*)(kg + (size_t)(NT - 2) * 64 * kvpitch); vreg = *(const u32x4*)(vg + (size_t)(NT - 2) * 64 * kvpitch); }
    const int qrow = wave * 32 + r32;
    const bool wact = wave < nact;
    bf16x8 qr[4];
    { const bf16_t* qp = Q + (size_t)(wact ? qrow : 0) * qpitch;
#pragma unroll
      for (int s = 0; s < 4; ++s) qr[s] = *(const bf16x8*)(qp + 16 * s + 8 * hi); }
    const int qpos = qpos0 + qrow;
    __syncthreads();
    float m_run = -1e30f, l_run = 0.f; f32x16 o[2]; o[0] = f32x16{}; o[1] = f32x16{};
    const int vbase = ((lane & 15) >> 2) * 64 + ((lane >> 4) & 1) * 32 + (lane & 3) * 8 + hi * 256;
    for (int it = 0; it < NT; ++it) {
        const int kt = NT - 1 - it;
        LAS unsigned char* Kb = lds + AT_K0 + (it & 1) * AT_KB; LAS unsigned char* Vb = lds + AT_V0 + (it & 1) * AT_VB;
        if (wact && 64 * kt <= qpos0 + wave * 32 + 31) {
            f32x16 p[2];
#pragma unroll
            for (int kb = 0; kb < 2; ++kb)
#pragma unroll
                for (int g4 = 0; g4 < 4; ++g4) { const f32x4 cv = *(LAS f32x4*)(cum2 + 64 * kt + 32 * kb + 8 * g4 + 4 * hi);
                    p[kb][4 * g4 + 0] = cv.x; p[kb][4 * g4 + 1] = cv.y; p[kb][4 * g4 + 2] = cv.z; p[kb][4 * g4 + 3] = cv.w; }
#pragma unroll
            for (int kb = 0; kb < 2; ++kb)
#pragma unroll
                for (int s = 0; s < 4; ++s) { const bf16x8 a = *(LAS bf16x8*)(Kb + (32 * kb + r32) * 144 + (16 * s + 8 * hi) * 2);
                    p[kb] = __builtin_amdgcn_mfma_f32_32x32x16_bf16(a, qr[s], p[kb], 0, 0, 0); }
            if (64 * kt + 63 > qpos0 + wave * 32) {
                float ninf = -INFINITY; asm volatile("" : "+v"(ninf));
#pragma unroll
                for (int kb = 0; kb < 2; ++kb)
#pragma unroll
                    for (int r = 0; r < 16; ++r) { const int key = 64 * kt + 32 * kb + crow(r, hi); if (key > qpos) p[kb][r] = ninf; }
            }
            float rm = p[0][0];
#pragma unroll
            for (int r = 1; r < 16; ++r) rm = fmaxf(rm, p[0][r]);
#pragma unroll
            for (int r = 0; r < 16; ++r) rm = fmaxf(rm, p[1][r]);
            rm = fmaxf(rm, shx(rm, 32, lane));
            const float mnew = fmaxf(m_run, rm);
            if (__builtin_amdgcn_ballot_w64(rm > m_run) != 0ull) {
                const float fsc = fexp2(m_run - mnew);
                l_run *= fsc;
#pragma unroll
                for (int r = 0; r < 16; ++r) { o[0][r] *= fsc; o[1][r] *= fsc; }
            }
            m_run = mnew;
            float ls = 0.f;
#pragma unroll
            for (int kb = 0; kb < 2; ++kb)
#pragma unroll
                for (int r = 0; r < 16; ++r) { p[kb][r] = fexp2(p[kb][r] - mnew); ls += p[kb][r]; }
            l_run += ls;
#pragma unroll
            for (int kb = 0; kb < 2; ++kb)
#pragma unroll
                for (int s = 0; s < 2; ++s) {
                    u32x4 pw; pw.x = pk2(p[kb][8 * s + 0], p[kb][8 * s + 1]); pw.y = pk2(p[kb][8 * s + 2], p[kb][8 * s + 3]); pw.z = pk2(p[kb][8 * s + 4], p[kb][8 * s + 5]); pw.w = pk2(p[kb][8 * s + 6], p[kb][8 * s + 7]);
                    const bf16x8 pf = __builtin_bit_cast(bf16x8, pw);
#pragma unroll
                    for (int db = 0; db < 2; ++db) {
                        LAS unsigned char* vp = Vb + db * 4096 + (32 * kb + 16 * s) * 64 + vbase;
                        const s16x4 lo = vtr(vp), h2 = vtr(vp + 512);
                        const bf16x8 vf = (bf16x8){lo[0], lo[1], lo[2], lo[3], h2[0], h2[1], h2[2], h2[3]};
                        o[db] = __builtin_amdgcn_mfma_f32_32x32x16_bf16(vf, pf, o[db], 0, 0, 0);
                    }
                }
        }
        if (it + 1 < NT) {
            LAS unsigned char* Kn = lds + AT_K0 + ((it + 1) & 1) * AT_KB; LAS unsigned char* Vn = lds + AT_V0 + ((it + 1) & 1) * AT_VB;
            *(LAS u32x4*)(Kn + kdst) = kreg; *(LAS u32x4*)(Vn + vdst) = vreg;
            if (it + 2 < NT) { kreg = *(const u32x4*)(kg + (size_t)(kt - 2) * 64 * kvpitch); vreg = *(const u32x4*)(vg + (size_t)(kt - 2) * 64 * kvpitch); }
        }
        __syncthreads();
    }
    l_run += shx(l_run, 32, lane);
    if (wact && qrow < nq) {
        const float rl = 1.0f / l_run;
        bf16_t* op = Q + (size_t)qrow * qpitch;
#pragma unroll
        for (int db = 0; db < 2; ++db)
#pragma unroll
            for (int g4 = 0; g4 < 4; ++g4) {
                u32x2 w; w.x = pk2(o[db][4 * g4 + 0] * rl, o[db][4 * g4 + 1] * rl); w.y = pk2(o[db][4 * g4 + 2] * rl, o[db][4 * g4 + 3] * rl);
                *(u32x2*)(op + 32 * db + 8 * g4 + 4 * hi) = w;
            }
    }
}

__device__ __forceinline__ void ffn_act_row(int m, int layer, bf16_t* PROJ, float* out, const float* st_ffn, const float* cw, const float* cb, int lane) {
    int b, t, L; bool isS;
    if (m < MP) { b = m >> 11; t = m & 2047; L = SEQ; isS = false; } else { const int mm = m - MP; b = mm >> 4; t = mm & 15; L = DSEQ; isS = true; }
    bf16_t* P = PROJ + (size_t)m * FF2;
    for (int oc = lane; oc < FF / 8; oc += 64) {
        const int c0 = oc * 8;
        float a[3][8];
#pragma unroll
        for (int d = 0; d < 3; ++d) {
            const int tau = t - 2 + d;
            if (tau >= 0) { unpack8(*(const u32x4*)(PROJ + (size_t)(m - 2 + d) * FF2 + c0), a[d]); }
            else if (isS) { const float* sp = st_ffn + ((size_t)(layer * DBATCH + b) * 2 + (tau + 2)) * FF + c0; const f32x4 x = *(const f32x4*)sp, y = *(const f32x4*)(sp + 4);
                a[d][0] = x.x; a[d][1] = x.y; a[d][2] = x.z; a[d][3] = x.w; a[d][4] = y.x; a[d][5] = y.y; a[d][6] = y.z; a[d][7] = y.w; }
            else {
#pragma unroll
                for (int e = 0; e < 8; ++e) a[d][e] = 0.f; }
        }
        float gg[8]; unpack8(*(const u32x4*)(P + FF + c0), gg);
        const float* w = cw + (size_t)layer * 3 * FF + c0; const float* bb = cb + (size_t)layer * FF + c0;
        float o[8];
#pragma unroll
        for (int e = 0; e < 8; ++e) { const float y = bb[e] + w[e] * a[0][e] + w[FF + e] * a[1][e] + w[2 * FF + e] * a[2][e]; o[e] = siluf_(y) * gg[e]; }
        *(u32x4*)(P + FF + c0) = pack8(o);
        if (t >= L - 2) {
            float* sp = out + (isS ? O_SFF + ((size_t)(layer * DBATCH + b) * 2 + (t - (L - 2))) * FF : O_PFF + ((size_t)(layer * NBATCH + b) * 2 + (t - (L - 2))) * FF) + c0;
            *(f32x4*)sp = (f32x4){a[2][0], a[2][1], a[2][2], a[2][3]}; *(f32x4*)(sp + 4) = (f32x4){a[2][4], a[2][5], a[2][6], a[2][7]};
        }
    }
}

constexpr int SD_BUF = 65536, SD_X = 0, SD_B = 32768, SD_C = 49152, SD_DT = 131072, SD_CUM = 132096, SD_YST = 133120, SD_END = 149504;
#define IMG16(img, row, ec) ((img) + ((ec) >> 5) * 4096 + (row) * 64 + ((ec) & 31) * 2)
#define IMG8(img, row, ec) IMG16(img, row, ec)

__device__ __forceinline__ void ssd_mix(LAS unsigned char* Brow, LAS unsigned char* Crow, LAS unsigned char* cumh, LAS unsigned char* dth, int sb, int qm, float cq, bf16x8& m0, bf16x8& m1) {
    f32x16 G = f32x16{};
#pragma unroll
    for (int ks = 0; ks < 8; ++ks) {
        const bf16x8 af = *(LAS bf16x8*)(Brow + sb * 2048 + (ks >> 1) * 4096 + (ks & 1) * 32);
        const bf16x8 bfg = *(LAS bf16x8*)(Crow + (ks >> 1) * 4096 + (ks & 1) * 32);
        G = __builtin_amdgcn_mfma_f32_32x32x16_bf16(af, bfg, G, 0, 0, 0);
    }
#pragma unroll
    for (int g4 = 0; g4 < 4; ++g4) {
        const f32x4 cv = *(LAS f32x4*)(cumh + (32 * sb + 8 * g4) * 4), dv = *(LAS f32x4*)(dth + (32 * sb + 8 * g4) * 4);
#pragma unroll
        for (int e = 0; e < 4; ++e) { const float wgt = fexp(fminf(cq - cv[e], 0.f)) * dv[e]; G[4 * g4 + e] = ((32 * sb + 8 * g4 + e) <= qm) ? G[4 * g4 + e] * wgt : 0.f; }
    }
    u32x4 pw; pw.x = pk2(G[0], G[1]); pw.y = pk2(G[2], G[3]); pw.z = pk2(G[4], G[5]); pw.w = pk2(G[6], G[7]); m0 = __builtin_bit_cast(bf16x8, pw);
    pw.x = pk2(G[8], G[9]); pw.y = pk2(G[10], G[11]); pw.z = pk2(G[12], G[13]); pw.w = pk2(G[14], G[15]); m1 = __builtin_bit_cast(bf16x8, pw);
}

__device__ __forceinline__ void ssd_unit(LAS unsigned char* lds, int j, int b, int g, int half, bool isS, bf16_t* PROJ, float* out,
                                         const float* st_conv, const float* st_ssm, const float* cw, const float* cbias, const float* dtb_, const float* alog, const float* dsk, int wv0) {
    const int tid = ltid(wv0), lane = tid & 63, wave = __builtin_amdgcn_readfirstlane(tid >> 6), r32 = lane & 31, hi = lane >> 5;
    const int m0 = isS ? MP + DSEQ * b : b * SEQ, nchunks = isS ? 1 : SEQ / 64, nvalid = isS ? DSEQ : 64;
    __syncthreads();
    if (wave >= 4) {
        const int ptid = tid - 256, oct = ptid & 63, seg = ptid >> 6;
        int col, sdst;
        if (oct < 32) { col = 2048 + g * 512 + half * 256 + oct * 8; sdst = SD_X + ((oct >> 3) * 2 + ((oct & 7) >> 2)) * 4096 + (oct & 3) * 16; }
        else if (oct < 48) { const int n0 = (oct - 32) * 8; col = 4096 + g * 128 + n0; sdst = SD_B + (n0 >> 5) * 4096 + (n0 & 31) * 2; }
        else { const int n0 = (oct - 48) * 8; col = 4608 + g * 128 + n0; sdst = SD_C + (n0 >> 5) * 4096 + (n0 & 31) * 2; }
        const int ch = col - 2048;
        float w[4][8], bs[8];
#pragma unroll
        for (int k = 0; k < 4; ++k) { const float* wp = cw + ((size_t)j * 4 + k) * 3072 + ch; const f32x4 x = *(const f32x4*)wp, y = *(const f32x4*)(wp + 4);
            w[k][0] = x.x; w[k][1] = x.y; w[k][2] = x.z; w[k][3] = x.w; w[k][4] = y.x; w[k][5] = y.y; w[k][6] = y.z; w[k][7] = y.w; }
        { const float* bp = cbias + (size_t)j * 3072 + ch; const f32x4 x = *(const f32x4*)bp, y = *(const f32x4*)(bp + 4);
            bs[0] = x.x; bs[1] = x.y; bs[2] = x.z; bs[3] = x.w; bs[4] = y.x; bs[5] = y.y; bs[6] = y.z; bs[7] = y.w; }
        const int s0 = 16 * seg;
#pragma unroll 1
        for (int c = 0; c < nchunks; ++c) {
            const int t0 = c * 64;
            LAS unsigned char* dbase = lds + (c & 1) * SD_BUF + sdst;
            u32x4 rw[19];
#pragma unroll
            for (int d = 0; d < 19; ++d) {
                const int sl = s0 - 3 + d, tau = t0 + sl;
                if (tau >= 0) { rw[d] = (sl < nvalid) ? *(const u32x4*)(PROJ + (size_t)(m0 + tau) * OINP + col) : (u32x4){0u, 0u, 0u, 0u}; }
                else if (isS) { const float* sp = st_conv + ((size_t)(j * DBATCH + b) * 3 + (tau + 3)) * 3072 + ch; const f32x4 x = *(const f32x4*)sp, y = *(const f32x4*)(sp + 4);
                    rw[d].x = pk2(x.x, x.y); rw[d].y = pk2(x.z, x.w); rw[d].z = pk2(y.x, y.y); rw[d].w = pk2(y.z, y.w); }
                else rw[d] = (u32x4){0u, 0u, 0u, 0u};
            }
            float f0[8], f1[8], f2[8], f3[8];
            unpack8(rw[0], f0); unpack8(rw[1], f1); unpack8(rw[2], f2);
#pragma unroll
            for (int i = 0; i < 16; ++i) {
                const int s = s0 + i;
                float o[8];
                unpack8(rw[i + 3], f3);
#pragma unroll
                for (int e = 0; e < 8; ++e) { const float y = bs[e] + w[0][e] * f0[e] + w[1][e] * f1[e] + w[2][e] * f2[e] + w[3][e] * f3[e]; o[e] = (s < nvalid) ? siluf_(y) : 0.f; }
                *(LAS u32x4*)(dbase + s * 64) = pack8(o);
#pragma unroll
                for (int e = 0; e < 8; ++e) { f0[e] = f1[e]; f1[e] = f2[e]; f2[e] = f3[e]; }
            }
            __syncthreads();
        }
    } else {
        const int hd = wave, h = 8 * g + 4 * half + hd;
        const float a_h = -fexp(alog[j * 32 + h]), dtb = dtb_[j * 32 + h], Dh = dsk[j * 32 + h];
        LAS float* dtv = (LAS float*)(lds + SD_DT) + hd * 64; LAS float* cumv = (LAS float*)(lds + SD_CUM) + hd * 64;
#define FRESH(x) int x = lane; asm volatile("" : "+v"(x))
#define O_RB(l) (((l) & 31) * 64 + ((l) >> 5) * 16)
#define O_RC(l) (((l) & 31) * 64 + ((l) >> 5) * 8)
#define O_TX(l) ((4 * ((l) >> 5) + (((l) & 15) >> 2)) * 64 + (((l) >> 4) & 1) * 32 + ((l) & 3) * 8)
#define O_T5(l) ((8 * ((l) >> 5) + (((l) & 15) >> 2)) * 64 + (((l) >> 4) & 1) * 32 + ((l) & 3) * 8)
#define O_YB(l) (((l) >> 5) * 512 + ((l) & 31) * 2)
#define O_G1(l) (((l) >> 3) * 128 + ((l) & 7) * 16)
#define O_G2(l) ((((l) & 7) >> 2) * 4096 + ((l) >> 3) * 64 + ((l) & 3) * 16)
#define O_H4(l) (((l) >> 5) * 16)
        f32x16 hT[4][2];
        const size_t st_off = ((size_t)((isS ? j * DBATCH : j * NBATCH) + b) * 32 + h) * 8192;
#pragma unroll
        for (int nb = 0; nb < 4; ++nb)
#pragma unroll
            for (int pb = 0; pb < 2; ++pb) {
                if (isS) {
                    const float* sp = st_ssm + st_off + (size_t)(32 * pb + r32) * 128 + 32 * nb + 4 * hi;
#pragma unroll
                    for (int g4 = 0; g4 < 4; ++g4) { const f32x4 v = *(const f32x4*)(sp + 8 * g4); hT[nb][pb][4 * g4] = v.x; hT[nb][pb][4 * g4 + 1] = v.y; hT[nb][pb][4 * g4 + 2] = v.z; hT[nb][pb][4 * g4 + 3] = v.w; }
                } else hT[nb][pb] = f32x16{};
            }
        LAS unsigned char* ystg = lds + SD_YST + hd * 4096;
        unsigned short dtr_next = (lane < nvalid) ? PROJ[(size_t)(m0 + lane) * OINP + 5120 + h] : (unsigned short)0;
#pragma unroll 1
        for (int c = 0; c < nchunks; ++c) {
            const int t0 = c * 64;
            LAS unsigned char* Xw = lds + (c & 1) * SD_BUF + SD_X + hd * 8192; LAS unsigned char* Bimg = lds + (c & 1) * SD_BUF + SD_B; LAS unsigned char* Cimg = lds + (c & 1) * SD_BUF + SD_C;
            {
                const bool valid = lane < nvalid;
                float dt = 0.f;
                const unsigned short dtr = dtr_next;
                if (c + 1 < nchunks) dtr_next = PROJ[(size_t)(m0 + t0 + 64 + lane) * OINP + 5120 + h];
                if (valid) dt = softplusf_(bf2f(dtr) + dtb);
                float cs = dt * a_h;
                int ln = lane; asm volatile("" : "+v"(ln));
#pragma unroll
                for (int o = 1; o < 64; o <<= 1) { const float tt = __builtin_bit_cast(float, __builtin_amdgcn_ds_bpermute((ln - o) << 2, __builtin_bit_cast(int, cs))); if (ln >= o) cs += tt; }
                dtv[lane] = dt; cumv[lane] = cs;
            }
            __syncthreads();
#pragma unroll 1
            for (int qb = 0; qb < 2; ++qb) {
                const int qrow = 32 * qb + r32;
                int qm = qrow - 4 * hi; asm volatile("" : "+v"(qm));
                const float cq = cumv[qrow];
#pragma unroll
                for (int nb = 0; nb < 4; ++nb) { asm volatile("" : "+v"(hT[nb][0])); asm volatile("" : "+v"(hT[nb][1])); }
                bf16x8 mixf[2][2];
                { FRESH(l1); LAS unsigned char* cumh = (LAS unsigned char*)cumv + O_H4(l1); LAS unsigned char* dth = (LAS unsigned char*)dtv + O_H4(l1);
                  ssd_mix(Bimg + O_RB(l1), Cimg + qb * 2048 + O_RB(l1), cumh, dth, 0, qm, cq, mixf[0][0], mixf[0][1]);
                  if (qb == 1) ssd_mix(Bimg + O_RB(l1), Cimg + qb * 2048 + O_RB(l1), cumh, dth, 1, qm, cq, mixf[1][0], mixf[1][1]);
                  else { mixf[1][0] = (bf16x8){0, 0, 0, 0, 0, 0, 0, 0}; mixf[1][1] = mixf[1][0]; } }
                f32x16 Y[2]; Y[0] = f32x16{}; Y[1] = f32x16{};
                FRESH(l2); LAS unsigned char* Cq = Cimg + qb * 2048 + O_RC(l2);
#pragma unroll
                for (int nb = 0; nb < 4; ++nb)
#pragma unroll
                    for (int tt = 0; tt < 2; ++tt) {
                        const s16x4 a0 = *(LAS s16x4*)(Cq + nb * 4096 + 32 * tt), a1 = *(LAS s16x4*)(Cq + nb * 4096 + 32 * tt + 16);
                        const bf16x8 af = (bf16x8){a0[0], a0[1], a0[2], a0[3], a1[0], a1[1], a1[2], a1[3]};
#pragma unroll
                        for (int pb = 0; pb < 2; ++pb) {
                            u32x4 pw; pw.x = pk2(hT[nb][pb][8 * tt + 0], hT[nb][pb][8 * tt + 1]); pw.y = pk2(hT[nb][pb][8 * tt + 2], hT[nb][pb][8 * tt + 3]);
                            pw.z = pk2(hT[nb][pb][8 * tt + 4], hT[nb][pb][8 * tt + 5]); pw.w = pk2(hT[nb][pb][8 * tt + 6], hT[nb][pb][8 * tt + 7]);
                            Y[pb] = __builtin_amdgcn_mfma_f32_32x32x16_bf16(af, __builtin_bit_cast(bf16x8, pw), Y[pb], 0, 0, 0);
                        }
                    }
                u32x4 zq[4];
                { FRESH(lz);
#pragma unroll
                  for (int it = 0; it < 2; ++it) { const int q = 32 * qb + 8 * it + (lz >> 3);
                      zq[it] = (q < nvalid) ? *(const u32x4*)(PROJ + (size_t)(m0 + t0 + q) * OINP + h * 64 + (lz & 7) * 8) : (u32x4){0u, 0u, 0u, 0u}; } }
#pragma unroll
                for (int g4 = 0; g4 < 4; ++g4) {
                    const f32x4 cv = *(LAS f32x4*)((LAS unsigned char*)cumv + O_H4(l2) + (32 * qb + 8 * g4) * 4);
#pragma unroll
                    for (int e = 0; e < 4; ++e) { const float f = fexp(cv[e]); Y[0][4 * g4 + e] *= f; Y[1][4 * g4 + e] *= f; }
                }
                FRESH(l3); LAS unsigned char* Xt = Xw + O_TX(l3);
#pragma unroll
                for (int sb = 0; sb < 2; ++sb)
#pragma unroll
                    for (int tp = 0; tp < 2; ++tp)
#pragma unroll
                        for (int pb = 0; pb < 2; ++pb) {
                            LAS unsigned char* xp = Xt + pb * 4096 + (32 * sb + 16 * tp) * 64;
                            const s16x4 lo = vtr(xp), h2 = vtr(xp + 512);
                            const bf16x8 xf = (bf16x8){lo[0], lo[1], lo[2], lo[3], h2[0], h2[1], h2[2], h2[3]};
                            Y[pb] = __builtin_amdgcn_mfma_f32_32x32x16_bf16(mixf[sb][tp], xf, Y[pb], 0, 0, 0);
                        }
                {
                    FRESH(l4); LAS unsigned char* yw = ystg + O_YB(l4);
#pragma unroll
                    for (int it = 2; it < 4; ++it) { const int q = 32 * qb + 8 * it + (l4 >> 3);
                        zq[it] = (q < nvalid) ? *(const u32x4*)(PROJ + (size_t)(m0 + t0 + q) * OINP + h * 64 + (l4 & 7) * 8) : (u32x4){0u, 0u, 0u, 0u}; }
#pragma unroll
                    for (int pb = 0; pb < 2; ++pb)
#pragma unroll
                        for (int r = 0; r < 16; ++r) *(LAS unsigned short*)(yw + ((r & 3) + 8 * (r >> 2)) * 128 + pb * 64) = f2bf(Y[pb][r]);
                    LDS_WAIT();
#pragma unroll
                    for (int it = 0; it < 4; ++it) {
                        const int row = 8 * it + (l4 >> 3), q = 32 * qb + row, p0 = (l4 & 7) * 8;
                        if (q < nvalid) {
                            float yv[8], xv[8], zv[8], ov[8];
                            unpack8(*(LAS u32x4*)(ystg + O_G1(l4) + it * 1024), yv);
                            unpack8(*(LAS u32x4*)(Xw + O_G2(l4) + qb * 2048 + it * 512), xv);
                            bf16_t* zp = PROJ + (size_t)(m0 + t0 + q) * OINP + h * 64 + p0;
                            unpack8(zq[it], zv);
#pragma unroll
                            for (int e = 0; e < 8; ++e) ov[e] = (yv[e] + Dh * xv[e]) * siluf_(zv[e]);
                            *(u32x4*)zp = pack8(ov);
                        }
                    }
                }
            }
            const float c63 = cumv[63];
            FRESH(l5);
#pragma unroll
            for (int it = 0; it < 8; ++it) {
                const int s = it * 8 + (l5 >> 3);
                LAS unsigned char* xp = Xw + O_G2(l5) + it * 512;
                const float w5 = dtv[s] * fexp(c63 - cumv[s]);
                float f[8]; unpack8(*(LAS u32x4*)xp, f);
#pragma unroll
                for (int e = 0; e < 8; ++e) f[e] *= w5;
                *(LAS u32x4*)xp = pack8(f);
            }
            const float dec = fexp(c63);
#pragma unroll
            for (int nb = 0; nb < 4; ++nb)
#pragma unroll
                for (int pb = 0; pb < 2; ++pb)
#pragma unroll
                    for (int r = 0; r < 16; ++r) hT[nb][pb][r] *= dec;
            LDS_WAIT();
            FRESH(l6); LAS unsigned char* X5 = Xw + O_T5(l6); LAS unsigned char* B5 = Bimg + O_T5(l6);
#pragma unroll
            for (int tt = 0; tt < 4; ++tt) {
                bf16x8 xb[2];
#pragma unroll
                for (int pb = 0; pb < 2; ++pb) {
                    LAS unsigned char* xp = X5 + pb * 4096 + tt * 1024;
                    const s16x4 lo = vtr(xp), h2 = vtr(xp + 256);
                    xb[pb] = (bf16x8){lo[0], lo[1], lo[2], lo[3], h2[0], h2[1], h2[2], h2[3]};
                }
#pragma unroll
                for (int nb = 0; nb < 4; ++nb) {
                    LAS unsigned char* bp0 = B5 + nb * 4096 + tt * 1024;
                    const s16x4 lo = vtr(bp0), h2 = vtr(bp0 + 256);
                    const bf16x8 af = (bf16x8){lo[0], lo[1], lo[2], lo[3], h2[0], h2[1], h2[2], h2[3]};
#pragma unroll
                    for (int pb = 0; pb < 2; ++pb) hT[nb][pb] = __builtin_amdgcn_mfma_f32_32x32x16_bf16(af, xb[pb], hT[nb][pb], 0, 0, 0);
                }
            }
        }
        int lofs = r32 * 128 + 4 * hi; asm volatile("" : "+v"(lofs));
        float* sp0 = out + (isS ? O_SSM : O_PSM) + st_off + lofs;
#pragma unroll
        for (int nb = 0; nb < 4; ++nb)
#pragma unroll
            for (int pb = 0; pb < 2; ++pb) {
                float* sp = sp0 + pb * 4096 + 32 * nb;
#pragma unroll
                for (int g4 = 0; g4 < 4; ++g4) *(f32x4*)(sp + 8 * g4) = (f32x4){hT[nb][pb][4 * g4], hT[nb][pb][4 * g4 + 1], hT[nb][pb][4 * g4 + 2], hT[nb][pb][4 * g4 + 3]};
            }
    }
}

__device__ __forceinline__ void odd_norm_row(int m, int j, bf16_t* PROJ, float* out, const float* normw, int lane) {
    int b, t, L; bool isS;
    if (m < MP) { b = m >> 11; t = m & 2047; L = SEQ; isS = false; } else { const int mm = m - MP; b = mm >> 4; t = mm & 15; L = DSEQ; isS = true; }
    bf16_t* P = PROJ + (size_t)m * OINP;
    u32x4 vw[4];
#pragma unroll
    for (int gi = 0; gi < 4; ++gi) vw[gi] = *(const u32x4*)(P + gi * 512 + lane * 8);
    if (t >= L - 3) {
        float* sp = out + (isS ? O_SSMC + ((size_t)(j * DBATCH + b) * 3 + (t - (L - 3))) * 3072 : O_PSMC + ((size_t)(j * NBATCH + b) * 3 + (t - (L - 3))) * 3072);
        for (int oc = lane; oc < 384; oc += 64) {
            float v[8]; unpack8(*(const u32x4*)(P + 2048 + oc * 8), v);
            *(f32x4*)(sp + oc * 8) = (f32x4){v[0], v[1], v[2], v[3]}; *(f32x4*)(sp + oc * 8 + 4) = (f32x4){v[4], v[5], v[6], v[7]};
        }
    }
    float ssg[4];
#pragma unroll
    for (int gi = 0; gi < 4; ++gi) { float v[8]; unpack8(vw[gi], v); float ss = 0.f;
#pragma unroll
        for (int e = 0; e < 8; ++e) ss += v[e] * v[e];
        ssg[gi] = ss; }
#pragma unroll
    for (int o = 1; o < 64; o <<= 1) { ssg[0] += shx(ssg[0], o, lane); ssg[1] += shx(ssg[1], o, lane); ssg[2] += shx(ssg[2], o, lane); ssg[3] += shx(ssg[3], o, lane); }
#pragma unroll
    for (int gi = 0; gi < 4; ++gi) {
        const int c0 = gi * 512 + lane * 8;
        float v[8]; unpack8(vw[gi], v);
        const float r = frsq((ssg[gi] + EPS * 512.f) * (1.f / 512.f));
        const float* w = normw + (size_t)j * 2048 + c0;
#pragma unroll
        for (int e = 0; e < 8; ++e) v[e] = v[e] * r * w[e];
        *(u32x4*)(P + c0) = pack8(v);
    }
}

__device__ __forceinline__ void odd_norm_row2(int mA, int mB, int j, bf16_t* PROJ, float* out, const float* normw, int lane) {
    bf16_t* PA = PROJ + (size_t)mA * OINP; bf16_t* PB = PROJ + (size_t)mB * OINP;
    u32x4 va[4], vb[4];
#pragma unroll
    for (int gi = 0; gi < 4; ++gi) { va[gi] = *(const u32x4*)(PA + gi * 512 + lane * 8); vb[gi] = *(const u32x4*)(PB + gi * 512 + lane * 8); }
#pragma unroll
    for (int r = 0; r < 2; ++r) {
        const int m = r ? mB : mA; bf16_t* P = r ? PB : PA;
        int b, t, L; bool isS;
        if (m < MP) { b = m >> 11; t = m & 2047; L = SEQ; isS = false; } else { const int mm = m - MP; b = mm >> 4; t = mm & 15; L = DSEQ; isS = true; }
        if (t >= L - 3) {
            float* sp = out + (isS ? O_SSMC + ((size_t)(j * DBATCH + b) * 3 + (t - (L - 3))) * 3072 : O_PSMC + ((size_t)(j * NBATCH + b) * 3 + (t - (L - 3))) * 3072);
            for (int oc = lane; oc < 384; oc += 64) {
                float v[8]; unpack8(*(const u32x4*)(P + 2048 + oc * 8), v);
                *(f32x4*)(sp + oc * 8) = (f32x4){v[0], v[1], v[2], v[3]}; *(f32x4*)(sp + oc * 8 + 4) = (f32x4){v[4], v[5], v[6], v[7]};
            }
        }
    }
    float sa[4], sb[4];
#pragma unroll
    for (int gi = 0; gi < 4; ++gi) { float v[8]; unpack8(va[gi], v); float ss = 0.f;
#pragma unroll
        for (int e = 0; e < 8; ++e) ss += v[e] * v[e];
        sa[gi] = ss; unpack8(vb[gi], v); ss = 0.f;
#pragma unroll
        for (int e = 0; e < 8; ++e) ss += v[e] * v[e];
        sb[gi] = ss; }
#pragma unroll
    for (int o = 1; o < 64; o <<= 1) {
#pragma unroll
        for (int gi = 0; gi < 4; ++gi) { sa[gi] += shx(sa[gi], o, lane); sb[gi] += shx(sb[gi], o, lane); } }
#pragma unroll
    for (int gi = 0; gi < 4; ++gi) {
        const int c0 = gi * 512 + lane * 8;
        const float* w = normw + (size_t)j * 2048 + c0;
        float wv[8];
#pragma unroll
        for (int e = 0; e < 8; ++e) wv[e] = w[e];
        float v[8]; unpack8(va[gi], v);
        const float ra = frsq((sa[gi] + EPS * 512.f) * (1.f / 512.f)), rb = frsq((sb[gi] + EPS * 512.f) * (1.f / 512.f));
#pragma unroll
        for (int e = 0; e < 8; ++e) v[e] = v[e] * ra * wv[e];
        *(u32x4*)(PA + c0) = pack8(v);
        unpack8(vb[gi], v);
#pragma unroll
        for (int e = 0; e < 8; ++e) v[e] = v[e] * rb * wv[e];
        *(u32x4*)(PB + c0) = pack8(v);
    }
}


#define XB_TMO      128
#define XB_XCNT(j)  (256  + 64 * (j))
#define XB_XSUB(j)  (1280 + 64 * (j))
#define XB_XGEN(j)  (2304 + 64 * (j))
#define XB_TOP      3328
#define XB_TOPGEN   3392
#define XCD_BAR_WORDS 3456
#define XB_SPIN_CAP (1u << 22)
__device__ __forceinline__ unsigned xb_ld(unsigned* p)              { return __hip_atomic_load(p, __ATOMIC_RELAXED, __HIP_MEMORY_SCOPE_AGENT); }
__device__ __forceinline__ unsigned xb_add(unsigned* p, unsigned v) { return __hip_atomic_fetch_add(p, v, __ATOMIC_RELAXED, __HIP_MEMORY_SCOPE_AGENT); }
__device__ __forceinline__ unsigned xb_xcc_id() { return (unsigned)__builtin_amdgcn_s_getreg((3 << 11) | 20) & 0xFu; }
#define XB_SPIN(cond, bar) do { unsigned _sp = 0; while (cond) { __builtin_amdgcn_s_sleep(1); \
    if ((++_sp & 255u) == 0u) { if (xb_ld(&(bar)[XB_TMO])) break; if (_sp > XB_SPIN_CAP) { atomicAdd(&(bar)[XB_TMO], 1u); break; } } } } while (0)
struct XcdBarrier { unsigned* bar; unsigned x; volatile LAS unsigned* st; };
__device__ __forceinline__ XcdBarrier xcd_barrier_post(unsigned* bar, volatile LAS unsigned* st) {
    XcdBarrier b; b.bar = bar; b.x = xb_xcc_id(); b.st = st;
    if (threadIdx.x == 0) (void)xb_add(&bar[XB_XCNT(b.x)], 1u);
    return b;
}
__device__ __forceinline__ void xcd_barrier_complete(unsigned* bar, unsigned x, unsigned& nloc, unsigned& nx) {
    const unsigned G = gridDim.x * gridDim.y * gridDim.z;
    unsigned sum, cnt, mine, sp = 0u;
    for (;;) {
        sum = 0u; cnt = 0u; mine = 0u;
#pragma unroll
        for (unsigned j = 0; j < 16; ++j) { const unsigned c = xb_ld(&bar[XB_XCNT(j)]); sum += c; cnt += (c > 0u) ? 1u : 0u; mine = (j == x) ? c : mine; }
        if (sum == G) break;
        __builtin_amdgcn_s_sleep(1);
        if ((++sp & 255u) == 0u) { if (xb_ld(&bar[XB_TMO])) break; if (sp > XB_SPIN_CAP) { atomicAdd(&bar[XB_TMO], 1u); break; } }
    }
    nloc = mine > 0u ? mine : 1u; nx = cnt > 0u ? cnt : 1u;
}
__device__ __forceinline__ void xcd_barrier(const XcdBarrier& b) {
    asm volatile("s_waitcnt vmcnt(0)" ::: "memory");
    __syncthreads();
    if (threadIdx.x == 0) {
        unsigned* bar = b.bar;
        __builtin_amdgcn_s_waitcnt(0);
        unsigned nloc = b.st[0], nx = b.st[1];
        if (nloc == 0u) { xcd_barrier_complete(bar, b.x, nloc, nx); b.st[0] = nloc; b.st[1] = nx; }
        const unsigned old = xb_add(&bar[XB_XSUB(b.x)], 1u);
        const unsigned gen = old / nloc;
        if (old + 1u == (gen + 1u) * nloc) {
            __builtin_amdgcn_fence(__ATOMIC_RELEASE, "agent");
            asm volatile("s_waitcnt vmcnt(0)" ::: "memory");
            const unsigned og = xb_add(&bar[XB_TOP], 1u);
            const unsigned tg = og / nx;
            if (og + 1u == (tg + 1u) * nx) xb_add(&bar[XB_TOPGEN], 1u);
            else XB_SPIN(xb_ld(&bar[XB_TOPGEN]) == tg, bar);
            __builtin_amdgcn_fence(__ATOMIC_ACQUIRE, "agent");
            xb_add(&bar[XB_XGEN(b.x)], 1u);
            asm volatile("s_waitcnt vmcnt(0)" ::: "memory");
        } else {
            XB_SPIN(xb_ld(&bar[XB_XGEN(b.x)]) == gen, bar);
            __builtin_amdgcn_fence(__ATOMIC_ACQUIRE, "agent");
            asm volatile("s_waitcnt vmcnt(0)" ::: "memory");
        }
    }
    __syncthreads();
}

struct Args { const float* in[29]; float* out; unsigned char* ws; };

__global__ void __launch_bounds__(NTHREADS, 2) fwd_kernel(Args a) {
    extern __shared__ __attribute__((aligned(16))) unsigned char lds_raw[];
    LAS unsigned char* lds = (LAS unsigned char*)lds_raw;
    cg::grid_group grid = cg::this_grid();
    volatile LAS unsigned* bst = (volatile LAS unsigned*)(lds + LDS_BYTES - 16);
    if (threadIdx.x == 0) { bst[0] = 0u; bst[1] = 0u; }
    __syncthreads();
    const XcdBarrier xbar = xcd_barrier_post((unsigned*)ARG_WS, bst);
#define GRID_BAR() xcd_barrier(xbar)
    const int G = gridDim.x, ngw = G * NWAVES;
    const int wv0 = __builtin_amdgcn_readfirstlane(threadIdx.x >> 6);
#define PHASE_IDS() const int tid = ltid(wv0), lane = tid & 63, wave = __builtin_amdgcn_readfirstlane(tid >> 6), gw = blockIdx.x * NWAVES + wave; (void)tid; (void)lane; (void)gw
    (void)a;
#define out ARG_OUT
#define WEIN ((bf16_t*)(ARG_WS + WS_WEIN))
#define WEOUT ((bf16_t*)(ARG_WS + WS_WEOUT))
#define WOIN ((bf16_t*)(ARG_WS + WS_WOIN))
#define WOOUT ((bf16_t*)(ARG_WS + WS_WOOUT))
#define WUP ((bf16_t*)(ARG_WS + WS_WUP))
#define WDN ((bf16_t*)(ARG_WS + WS_WDN))
#define KS ((bf16_t*)(ARG_WS + WS_KS))
#define VS ((bf16_t*)(ARG_WS + WS_VS))
#define XN ((bf16_t*)(ARG_WS + WS_XN))
#define PROJ ((bf16_t*)(ARG_WS + WS_PROJ))

    {
        PHASE_IDS();
        LAS float* scr = (LAS float*)(lds + wave * 8448);
        constexpr int TOT = 2 * 16 * 104 + 2 * 16 * 32 + 2 * 16 * 168 + 2 * 32 * 32 + 4 * 16 * 176 + 4 * 44 * 32;
        { const float* w11 = argp(11); const float* w16 = argp(16); const float* w17 = argp(17); const float* w24 = argp(24); const float* w25 = argp(25); const float* w28 = argp(28); const float* gmix = argp(9); const float* gffn = argp(10); unsigned char* ws_ = ARG_WS;
        for (int it0 = gw; it0 < TOT; it0 += ngw) {
            int it = it0;
            if (transpose_family(it, w11, (bf16_t*)(ws_ + WS_WEIN), 2, 1024, EIN, EINP, 1, gmix, 2, 0, scr, lane)) continue;
            if (transpose_family(it, w16, (bf16_t*)(ws_ + WS_WEOUT), 2, 1024, 1024, 1024, 0, nullptr, 0, 0, scr, lane)) continue;
            if (transpose_family(it, w17, (bf16_t*)(ws_ + WS_WOIN), 2, 1024, OIN, OINP, 0, gmix, 2, 1, scr, lane)) continue;
            if (transpose_family(it, w24, (bf16_t*)(ws_ + WS_WOOUT), 2, 2048, 1024, 1024, 0, nullptr, 0, 0, scr, lane)) continue;
            if (transpose_family(it, w25, (bf16_t*)(ws_ + WS_WUP), 4, 1024, FF2, FF2, 2, gffn, 1, 0, scr, lane)) continue;
            transpose_family(it, w28, (bf16_t*)(ws_ + WS_WDN), 4, FF, 1024, 1024, 0, nullptr, 0, 0, scr, lane);
        } }
        { const float* x0 = argp(0); const float* x1 = argp(1); bf16_t* xn_ = XN; float* o_ = out; float* rs_ = (float*)(ARG_WS + WS_RS);
          for (int m = gw; m < MV; m += ngw) {
            const float* xr = (m < MP) ? x0 + (size_t)m * DM : x1 + (size_t)(m - MP) * DM;
            cast_row(xr, xn_ + (size_t)m * DM, (m < MP) ? nullptr : o_ + (size_t)m * DM, rs_ + m, lane);
          } }
    }
    grid.sync();

    for (int hl = 0; hl < 8; ++hl) {
        const int layer = hl >> 1, j = layer >> 1;
        const bool ffn = hl & 1, odd = layer & 1;
        {
            const bf16_t* Bt = ffn ? WUP + (size_t)layer * FF2 * 1024 : (odd ? WOIN + (size_t)j * OINP * 1024 : WEIN + (size_t)j * EINP * 1024);
            const int N = ffn ? FF2 : (odd ? OINP : EINP);
            pg8::Gemm g{XN, Bt, 1024, 1024, MT, N}; pg8::StaticOrder S; S.init(MP, N, 1024, G, (int)blockIdx.x, 0);
#ifndef T_NO_G1
            if (ffn) {
                pg8::EpiFfnUp E{layer};
                pg8::gemm_phase<pg8::EpiFfnUp>(lds, g, S, E, wv0);
            } else {
                pg8::EpiStoreBf16 E{PROJ, N, (const float*)(ARG_WS + WS_RS)};
                pg8::gemm_phase<pg8::EpiStoreBf16>(lds, g, S, E, wv0);
            }
#endif
        }
        GRID_BAR();
        if (ffn) {
            {
                const int gt = blockIdx.x * NTHREADS + ltid(wv0), ngt = G * NTHREADS;
                const float* THA = (const float*)(ARG_WS + WS_THA); const float* THG = (const float*)(ARG_WS + WS_THG); bf16_t* H = PROJ;
                const float* cw = argp(26) + (size_t)layer * 3 * FF; const float* cb = argp(27) + (size_t)layer * FF;
                for (int idx = gt; idx < 256 * 2 * (FF / 4); idx += ngt) {
                    const int c4 = idx % (FF / 4), r = idx / (FF / 4), rr = r & 1, pm = r >> 1;
                    if ((pm & 7) == 0) continue;
                    const int ch = c4 * 4;
                    const f32x4 cur = *(const f32x4*)(THA + ((size_t)pm * 4 + 2 + rr) * FF + ch);
                    const f32x4 l255 = *(const f32x4*)(THA + ((size_t)(pm - 1) * 4 + 1) * FF + ch);
                    const f32x4 p1 = rr ? *(const f32x4*)(THA + ((size_t)pm * 4 + 2) * FF + ch) : l255;
                    const f32x4 p2 = rr ? l255 : *(const f32x4*)(THA + ((size_t)(pm - 1) * 4 + 0) * FF + ch);
                    const f32x4 gv = *(const f32x4*)(THG + ((size_t)pm * 2 + rr) * FF + ch);
                    const f32x4 y = *(const f32x4*)(cb + ch) + *(const f32x4*)(cw + ch) * p2 + *(const f32x4*)(cw + FF + ch) * p1 + *(const f32x4*)(cw + 2 * FF + ch) * cur;
                    u32x2 w; w.x = pk2(siluf_(y.x) * gv.x, siluf_(y.y) * gv.y); w.y = pk2(siluf_(y.z) * gv.z, siluf_(y.w) * gv.w);
                    *(u32x2*)(H + (size_t)(pm * 256 + rr) * FF + ch) = w;
                }
                const float* T = (const float*)(ARG_WS + WS_TMPS); const float* st = argp(8) + (size_t)layer * DBATCH * 2 * FF; float* os = out + O_SFF + (size_t)layer * DBATCH * 2 * FF;
                for (int idx = gt; idx < MS * (FF / 4); idx += ngt) {
                    const int c4 = idx % (FF / 4), row = idx / (FF / 4), t = row & 15, bb_ = row >> 4, ch = c4 * 4;
                    const f32x4 cur = *(const f32x4*)(T + (size_t)row * 2 * FF + ch), gv = *(const f32x4*)(T + (size_t)row * 2 * FF + FF + ch);
                    const f32x4 p1 = (t >= 1) ? *(const f32x4*)(T + (size_t)(row - 1) * 2 * FF + ch) : *(const f32x4*)(st + ((size_t)bb_ * 2 + 1) * FF + ch);
                    const f32x4 p2 = (t >= 2) ? *(const f32x4*)(T + (size_t)(row - 2) * 2 * FF + ch) : *(const f32x4*)(st + ((size_t)bb_ * 2 + t) * FF + ch);
                    const f32x4 y = *(const f32x4*)(cb + ch) + *(const f32x4*)(cw + ch) * p2 + *(const f32x4*)(cw + FF + ch) * p1 + *(const f32x4*)(cw + 2 * FF + ch) * cur;
                    u32x2 w; w.x = pk2(siluf_(y.x) * gv.x, siluf_(y.y) * gv.y); w.y = pk2(siluf_(y.z) * gv.z, siluf_(y.w) * gv.w);
                    *(u32x2*)(H + (size_t)(MP + row) * FF + ch) = w;
                    if (t >= 14) *(f32x4*)(os + ((size_t)bb_ * 2 + (t - 14)) * FF + ch) = cur;
                }
            }
            GRID_BAR();
        } else if (!odd) {
            {
            PHASE_IDS();
#ifndef T_NO_PREP
            { bf16_t* pj_ = PROJ; float* o_ = out; const float* p5 = argp(5); const float* p12 = argp(12); const float* p13 = argp(13); const float* p14 = argp(14); const float* p15 = argp(15); bf16_t* ks_ = KS; bf16_t* vs_ = VS;
              for (int m = gw; m < MV; m += ngw) even_prep_row(m, j, pj_, o_, p5, p12, p13, p14, p15, ks_, vs_, lane); }
#endif
            {
                const int gt = blockIdx.x * NTHREADS + tid, ngt = G * NTHREADS; const float* ck_ = argp(2); const float* cv_ = argp(3); bf16_t* ks_ = KS; bf16_t* vs_ = VS;
                for (int idx = gt; idx < DBATCH * PAST * 64; idx += ngt) {
                    const int bb = idx >> 16, rem = idx & 65535, i = rem >> 6, c8 = rem & 63;
                    const size_t so = ((size_t)(j * DBATCH + bb) * PAST + i) * 512 + c8 * 8; const size_t dof = ((size_t)bb * KSROWS + i) * 512 + c8 * 8;
                    { const f32x4 x = *(const f32x4*)(ck_ + so), y = *(const f32x4*)(ck_ + so + 4); u32x4 w; w.x = pk2(x.x, x.y); w.y = pk2(x.z, x.w); w.z = pk2(y.x, y.y); w.w = pk2(y.z, y.w); *(u32x4*)(ks_ + dof) = w; }
                    { const f32x4 x = *(const f32x4*)(cv_ + so), y = *(const f32x4*)(cv_ + so + 4); u32x4 w; w.x = pk2(x.x, x.y); w.y = pk2(x.z, x.w); w.z = pk2(y.x, y.y); w.w = pk2(y.z, y.w); *(u32x4*)(vs_ + dof) = w; }
                }
                for (int idx = gt; idx < DBATCH * 48 * 64; idx += ngt) {
                    const int bb = idx / (48 * 64), rem = idx % (48 * 64), i = 1040 + (rem >> 6), c8 = rem & 63;
                    const size_t dof = ((size_t)bb * KSROWS + i) * 512 + c8 * 8;
                    *(u32x4*)(ks_ + dof) = (u32x4){0u, 0u, 0u, 0u}; *(u32x4*)(vs_ + dof) = (u32x4){0u, 0u, 0u, 0u};
                }
            }
            }
            GRID_BAR();
#ifndef T_NO_ATT
            for (int u = blockIdx.x; u < 2048 + 64; u += G) {
                if (u < 2048) {
                    const int qb = 7 - (u >> 8), bh = u & 255, b = bh >> 3, h = bh & 7;
                    bf16_t* base = PROJ + (size_t)(b * SEQ) * EINP + h * 64;
                    attn_unit(lds, base + (size_t)(256 * qb) * EINP + 1536, EINP, base + 2048, base + 2560, EINP, 256, 256 * qb, 256 * (qb + 1),
                              nullptr, 0, out + O_PLF + ((size_t)(j * NBATCH + b) * SEQ) * 8 + h, 8, wv0, (G == 256) && (u >= G));
                } else {
                    const int idx = u - 2048, b = idx >> 3, h = idx & 7;
                    bf16_t* base = PROJ + (size_t)(MP + DSEQ * b) * EINP + h * 64;
                    attn_unit(lds, base + 1536, EINP, KS + (size_t)b * KSROWS * 512 + h * 64, VS + (size_t)b * KSROWS * 512 + h * 64, 512, DSEQ, PAST, PAST + DSEQ,
                              argp(4) + ((size_t)(j * DBATCH + b) * PAST) * 8 + h, PAST, out + O_SLF + ((size_t)(j * DBATCH + b) * DSEQ) * 8 + h, 1, wv0, false);
                }
            }
#endif
            GRID_BAR();
        } else {
#ifndef T_NO_SSD
            for (int u = blockIdx.x; u < 256 + 64; u += G) {
                const bool isS = u >= 256; const int idx = isS ? u - 256 : u;
                ssd_unit(lds, j, idx >> 3, (idx >> 1) & 3, idx & 1, isS, PROJ, out, argp(6), argp(7), argp(18), argp(19), argp(20), argp(21), argp(22), wv0);
            }
#endif
            GRID_BAR();
            { PHASE_IDS(); bf16_t* pj_ = PROJ; float* o_ = out; const float* p23 = argp(23); for (int m = gw; m < MV; m += 2 * ngw) { const int m2 = m + ngw; if (m2 < MV) odd_norm_row2(m, m2, j, pj_, o_, p23, lane); else odd_norm_row(m, j, pj_, o_, p23, lane); } }
            GRID_BAR();
        }
        {
            const bf16_t* A = (ffn || odd) ? PROJ : PROJ + 1024;
            const int lda = ffn ? FF : (odd ? OINP : EINP);
            const int K = ffn ? FF : (odd ? 2048 : 1024);
            const bf16_t* Bt = ffn ? WDN + (size_t)layer * 1024 * FF : (odd ? WOOUT + (size_t)j * 1024 * 2048 : WEOUT + (size_t)j * 1024 * 1024);
            pg8::Gemm g{A, Bt, lda, K, MT, 1024}; pg8::StaticOrder S; S.init(MP, 1024, K, G, (int)blockIdx.x, 4);
            pg8::EpiResid E{out, XN, (float*)(ARG_WS + WS_SS), MV, K / 64, hl == 7};
#ifndef T_NO_G2
            pg8::gemm_phase<pg8::EpiResid>(lds, g, S, E, wv0);
#endif
        }
        GRID_BAR();
        if (hl < 7) {
            PHASE_IDS();
            float* o_ = out; bf16_t* xn_ = XN; const float* ss_ = (const float*)(ARG_WS + WS_SS); float* rs_ = (float*)(ARG_WS + WS_RS);
            { const int m = MP + gw; if (m < MV) cast_row(o_ + (size_t)m * DM, xn_ + (size_t)m * DM, nullptr, rs_ + m, lane); }
            int gstr = G * NTHREADS; asm volatile("" : "+s"(gstr));
#pragma unroll 1
            for (int m = blockIdx.x * NTHREADS + tid; m < MP; m += gstr) {
                const f32x4* sp = (const f32x4*)(ss_ + (size_t)m * 16); const f32x4 s0 = sp[0], s1 = sp[1], s2 = sp[2], s3 = sp[3];
                const float tot = ((s0.x + s0.y) + (s0.z + s0.w)) + ((s1.x + s1.y) + (s1.z + s1.w)) + ((s2.x + s2.y) + (s2.z + s2.w)) + ((s3.x + s3.y) + (s3.z + s3.w));
                rs_[m] = frsq((tot + EPS * DM) * (1.f / DM));
            }
            GRID_BAR();
        }
    }
#undef out
#undef WEIN
#undef WEOUT
#undef WOIN
#undef WOOUT
#undef WUP
#undef WDN
#undef KS
#undef VS
#undef XN
#undef PROJ
}

extern "C" void kernel_launch(void* const* d_in, const int* in_sizes, int n_in, void* d_out, int out_size, void* d_ws, size_t ws_size, hipStream_t stream) {
    static int grid = 0;
    if (grid == 0) {
        if (n_in != 29 || (size_t)out_size != O_END || ws_size < WS_END) { fprintf(stderr, "kernel_launch: unexpected sizes n_in %d out %d (want %zu) ws %zu (want %zu)\n", n_in, out_size, (size_t)O_END, ws_size, (size_t)WS_END); grid = -1; return; }
        int dev = 0, cus = 0, per_cu = 0;
        hipGetDevice(&dev); hipDeviceGetAttribute(&cus, hipDeviceAttributeMultiprocessorCount, dev);
        if (hipFuncSetAttribute((const void*)fwd_kernel, hipFuncAttributeMaxDynamicSharedMemorySize, LDS_BYTES) != hipSuccess) { fprintf(stderr, "kernel_launch: hipFuncSetAttribute failed\n"); grid = -1; return; }
        if (hipOccupancyMaxActiveBlocksPerMultiprocessor(&per_cu, (const void*)fwd_kernel, NTHREADS, LDS_BYTES) != hipSuccess || per_cu < 1) { fprintf(stderr, "kernel_launch: occupancy query says %d\n", per_cu); per_cu = 1; }
        (void)hipGetLastError();
        grid = cus;
        fprintf(stderr, "kernel_launch: grid %d (cus %d, per_cu %d)\n", grid, cus, per_cu);
    }
    if (grid < 0) return;
    if (hipMemsetAsync(d_ws, 0, 16384, stream) != hipSuccess) { fprintf(stderr, "kernel_launch: memset of barrier words failed\n"); return; }
    Args a{};
    for (int i = 0; i < 29; ++i) a.in[i] = (const float*)d_in[i];
    a.out = (float*)d_out; a.ws = (unsigned char*)d_ws;
    void* args[] = {&a};
    hipError_t e = hipLaunchCooperativeKernel((const void*)fwd_kernel, dim3(grid), dim3(NTHREADS), args, LDS_BYTES, stream);
    if (e != hipSuccess) fprintf(stderr, "cooperative launch failed: %s (grid %d)\n", hipGetErrorString(e), grid);
}
```

```cpp
#include <hip/hip_runtime.h>
#include <hip/hip_cooperative_groups.h>
#include <cstdio>
#include <cstdint>
#include <cmath>
namespace cg = cooperative_groups;

#define LAS __attribute__((address_space(3)))
typedef unsigned short bf16_t;
typedef short bf16x8 __attribute__((ext_vector_type(8)));
typedef short s16x4 __attribute__((ext_vector_type(4)));
typedef float f32x4 __attribute__((ext_vector_type(4)));
typedef float f32x2 __attribute__((ext_vector_type(2)));
typedef float f32x16 __attribute__((ext_vector_type(16)));
typedef unsigned u32x4 __attribute__((ext_vector_type(4)));
typedef unsigned u32x2 __attribute__((ext_vector_type(2)));
typedef __bf16 bf16x2_t __attribute__((ext_vector_type(2)));

constexpr int DM = 1024, NBATCH = 32, SEQ = 2048, DBATCH = 8, DSEQ = 16, PAST = 1024;
constexpr int MP = NBATCH * SEQ;
constexpr int MS = DBATCH * DSEQ;
constexpr int MV = MP + MS;
constexpr int MT = 65792;
constexpr int EIN = 3080, EINP = 3328;
constexpr int OIN = 5152, OINP = 5376;
constexpr int FF = 2816, FF2 = 5632;
constexpr int NWAVES = 8, NTHREADS = 512;
constexpr float EPS = 1e-6f;
constexpr float LOG2E = 1.4426950408889634f;
constexpr int KSROWS = 1088;

constexpr size_t O_Y = 0;
constexpr size_t O_PK = (size_t)MV * DM;
constexpr size_t O_PV = O_PK + (size_t)2 * NBATCH * SEQ * 512;
constexpr size_t O_PLF = O_PV + (size_t)2 * NBATCH * SEQ * 512;
constexpr size_t O_PSC = O_PLF + (size_t)2 * NBATCH * SEQ * 8;
constexpr size_t O_PSMC = O_PSC + (size_t)2 * NBATCH * 2 * 512;
constexpr size_t O_PSM = O_PSMC + (size_t)2 * NBATCH * 3 * 3072;
constexpr size_t O_PFF = O_PSM + (size_t)2 * NBATCH * 32 * 64 * 128;
constexpr size_t O_SK = O_PFF + (size_t)4 * NBATCH * 2 * FF;
constexpr size_t O_SV = O_SK + (size_t)2 * DBATCH * DSEQ * 512;
constexpr size_t O_SLF = O_SV + (size_t)2 * DBATCH * DSEQ * 512;
constexpr size_t O_SSC = O_SLF + (size_t)2 * DBATCH * DSEQ * 8;
constexpr size_t O_SSMC = O_SSC + (size_t)2 * DBATCH * 2 * 512;
constexpr size_t O_SSM = O_SSMC + (size_t)2 * DBATCH * 3 * 3072;
constexpr size_t O_SFF = O_SSM + (size_t)2 * DBATCH * 32 * 64 * 128;
constexpr size_t O_END = O_SFF + (size_t)4 * DBATCH * 2 * FF;

constexpr size_t WS_WEIN = 1u << 20;
constexpr size_t WS_WEOUT = WS_WEIN + (size_t)2 * EINP * 1024 * 2;
constexpr size_t WS_WOIN = WS_WEOUT + (size_t)2 * 1024 * 1024 * 2;
constexpr size_t WS_WOOUT = WS_WOIN + (size_t)2 * OINP * 1024 * 2;
constexpr size_t WS_WUP = WS_WOOUT + (size_t)2 * 1024 * 2048 * 2;
constexpr size_t WS_WDN = WS_WUP + (size_t)4 * FF2 * 1024 * 2;
constexpr size_t WS_KS = WS_WDN + (size_t)4 * 1024 * FF * 2;
constexpr size_t WS_VS = WS_KS + (size_t)DBATCH * KSROWS * 512 * 2;
constexpr size_t WS_XN = WS_VS + (size_t)DBATCH * KSROWS * 512 * 2;
constexpr size_t WS_PROJ = WS_XN + (size_t)MT * 1024 * 2;
constexpr size_t WS_SS = WS_PROJ + (size_t)MT * FF2 * 2;
constexpr size_t WS_THA = WS_SS + (size_t)MT * 16 * 4;
constexpr size_t WS_THG = WS_THA + (size_t)257 * 4 * FF * 4;
constexpr size_t WS_RS = WS_THG + (size_t)257 * 2 * FF * 4;
constexpr size_t WS_TMPS = WS_RS + (size_t)MT * 4;
constexpr size_t WS_END = WS_TMPS + (size_t)128 * 2 * FF * 4;
static_assert(WS_END <= (size_t)1073741824, "workspace map exceeds 1 GiB");
static_assert(WS_WEIN % 256 == 0 && WS_XN % 256 == 0 && WS_PROJ % 256 == 0 && WS_KS % 256 == 0, "alignment");

constexpr int LDS_BYTES = 155648;

__device__ __forceinline__ unsigned pk2(float lo, float hi) { f32x2 v = {lo, hi}; bf16x2_t b = __builtin_convertvector(v, bf16x2_t); return __builtin_bit_cast(unsigned, b); }
__device__ __forceinline__ unsigned short f2bf(float f) { return (unsigned short)(pk2(f, 0.f) & 0xffffu); }
__device__ __forceinline__ float bf2f(unsigned short h) { return __uint_as_float(((unsigned)h) << 16); }
__device__ __forceinline__ float bflo(unsigned w) { return __uint_as_float(w << 16); }
__device__ __forceinline__ float bfhi(unsigned w) { return __uint_as_float(w & 0xffff0000u); }
__device__ __forceinline__ float shx(float v, int mask, int lane) { return __builtin_bit_cast(float, __builtin_amdgcn_ds_bpermute((lane ^ mask) << 2, __builtin_bit_cast(int, v))); }
__device__ __forceinline__ float shup(float v, int d, int lane) { return __builtin_bit_cast(float, __builtin_amdgcn_ds_bpermute((lane - d) << 2, __builtin_bit_cast(int, v))); }
template <int N> __device__ __forceinline__ float dpp_shr(float v) { return __builtin_bit_cast(float, __builtin_amdgcn_update_dpp(0, __builtin_bit_cast(int, v), 0x110 + N, 0xF, 0xF, false)); }
__device__ __forceinline__ float wave_sum(float v, int lane) {
#pragma unroll
    for (int o = 1; o < 64; o <<= 1) v += shx(v, o, lane);
    return v;
}
__device__ __forceinline__ float fexp2(float x) { return __builtin_amdgcn_exp2f(x); }
__device__ __forceinline__ float frsq(float x) { return __builtin_amdgcn_rsqf(x); }
__device__ __forceinline__ float fexp(float x) { return __builtin_amdgcn_exp2f(x * LOG2E); }
__device__ __forceinline__ float sigmoidf_(float x) { return __builtin_amdgcn_rcpf(1.f + fexp(-x)); }
__device__ __forceinline__ float siluf_(float x) { return x * sigmoidf_(x); }
__device__ __forceinline__ float log1pexp_neg(float ax) { return 0.6931471805599453f * __builtin_amdgcn_logf(1.f + fexp(-ax)); }
__device__ __forceinline__ float softplusf_(float x) { return fmaxf(x, 0.f) + log1pexp_neg(fabsf(x)); }
__device__ __forceinline__ int crow(int r, int hi) { return (r & 3) + 8 * (r >> 2) + 4 * hi; }
#define LDS_WAIT() asm volatile("s_waitcnt lgkmcnt(0)" ::: "memory")
__device__ __forceinline__ const float* argp(int i) {
    typedef const float* fptr;
    const __attribute__((address_space(4))) fptr* kp = (const __attribute__((address_space(4))) fptr*)__builtin_amdgcn_kernarg_segment_ptr();
    asm volatile("" : "+s"(kp));
    return kp[i];
}
#define ARG_OUT ((float*)argp(29))
#define ARG_WS ((unsigned char*)argp(30))
__device__ __forceinline__ int fresh_lane() { int l = (int)__builtin_amdgcn_mbcnt_hi(~0u, __builtin_amdgcn_mbcnt_lo(~0u, 0u)); asm volatile("" : "+v"(l)); return l; }
__device__ __forceinline__ int ltid(int wv0) { int t = wv0 * 64 + (int)__builtin_amdgcn_mbcnt_hi(~0u, __builtin_amdgcn_mbcnt_lo(~0u, 0u)); asm volatile("" : "+v"(t)); return t; }

namespace pg8 {
constexpr int BM = 256, BK = 64, HALF = 128, HTB = HALF * BK * 2, STAGE_BYTES = 8 * HTB, NXCD = 8, WGM = 8;
__host__ __device__ __forceinline__ int lds_byte(int r, int c) { const int st = (r >> 4) * 2 + (c >> 5), rr = r & 15, cc = c & 31, ob = rr * 64 + cc * 2; return st * 1024 + (ob ^ (((ob >> 9) & 1) << 5)); }
__host__ __device__ __forceinline__ void stage_rc(int b, int& R, int& C) { const int st = b / 1024, sb = b % 1024, swz = sb ^ (((sb >> 9) & 1) << 5); R = (st >> 1) * 16 + swz / 64; C = (st & 1) * 32 + (swz % 64) / 2; }
__host__ __device__ __forceinline__ int perm32(int rho) { const int n = rho >> 4, i = rho & 15; return 8 * (i >> 2) + 4 * n + (i & 3); }
struct Unit { int pm, pn, kt0, nkt; };
struct Gemm { const bf16_t* A; const bf16_t* Bt; int lda, K, M, N; };
struct StaticOrder {
    int nM, nN, nmain, G, c, ntf, nsplit, ktc;
    __host__ __device__ void init(int Mmain, int N, int K, int G_, int c_, int ktc_) { nM = Mmain / BM; nN = N / BM; nmain = nM * nN; G = G_; c = c_; ntf = K / BK; ktc = ktc_ ? ktc_ : ntf; nsplit = (ntf + ktc - 1) / ktc; }
    __host__ __device__ bool next(int i, Unit& u) const {
        const long L = (long)i * G + c;
        if (L >= nmain) { const int s = (int)(L - nmain); if (s >= nN * nsplit) return false;
            u.pm = nM;
            if (nsplit == 1) { u.pn = s; u.kt0 = 0; u.nkt = ntf; }
            else { u.pn = s & 3; u.kt0 = (s >> 2) * ktc; u.nkt = (ntf - u.kt0) < ktc ? (ntf - u.kt0) : ktc; }
            return true; }
        int wgid = (int)L; { const int q = nmain / NXCD, r = nmain % NXCD, xcd = wgid % NXCD, off = wgid / NXCD; wgid = (xcd < r ? xcd * (q + 1) : r * (q + 1) + (xcd - r) * q) + off; }
        const int nig = WGM * nN, gid = wgid / nig, fm = gid * WGM, gsz = (nM - fm) < WGM ? (nM - fm) : WGM;
        u.pm = fm + ((wgid % nig) % gsz); u.pn = (wgid % nig) / gsz; u.kt0 = 0; u.nkt = ntf; return true;
    }
};
struct EpiStoreBf16 {
    static constexpr bool PERM = true;
    bf16_t* O; int ldc; const float* SS;
    __device__ __forceinline__ void operator()(const f32x4 (&acc)[2][2][4][2], const Unit& u, int wr, int wc, int, int, LAS unsigned char*) const {
        const int ln_ = fresh_lane(), fr = ln_ & 15, fq = ln_ >> 4;
        const int row0 = u.pm * BM + wr * 64 + fr; const int col0 = u.pn * BM + wc * 32 + 8 * fq;
        float rsv[2][4];
#pragma unroll
        for (int ai = 0; ai < 2; ++ai)
#pragma unroll
            for (int m = 0; m < 4; ++m) rsv[ai][m] = SS[row0 + ai * HALF + m * 16];
#pragma unroll
        for (int ai = 0; ai < 2; ++ai)
#pragma unroll
            for (int m = 0; m < 4; ++m) { bf16_t* rowp = O + (size_t)(row0 + ai * HALF + m * 16) * ldc + col0;
                const float rs = rsv[ai][m];
#pragma unroll
                for (int bj = 0; bj < 2; ++bj) { const f32x4 v0 = acc[ai][bj][m][0] * rs, v1 = acc[ai][bj][m][1] * rs;
                    u32x4 w; w.x = pk2(v0[0], v0[1]); w.y = pk2(v0[2], v0[3]); w.z = pk2(v1[0], v1[1]); w.w = pk2(v1[2], v1[3]);
                    *(u32x4*)(rowp + bj * HALF) = w; } }
    }
};
struct EpiResid {
    static constexpr bool PERM = false;
    float* X; bf16_t* XB; float* SSn; int mvalid, ntfull; bool final_f32;
    __device__ __forceinline__ void operator()(const f32x4 (&acc)[2][2][4][2], const Unit& u, int wr, int wc, int, int, LAS unsigned char*) const {
        const int ln_ = fresh_lane(), fr = ln_ & 15, fq = ln_ >> 4;
        const int col0 = u.pn * BM + wc * 32 + 4 * fq;
        if (u.nkt != ntfull) {
#pragma unroll
            for (int m = 0; m < 4; ++m) { const int row = u.pm * BM + wr * 64 + m * 16 + fr;
                if (row < mvalid) { float* rp = X + (size_t)row * DM + col0;
#pragma unroll
                    for (int bj = 0; bj < 2; ++bj)
#pragma unroll
                        for (int n = 0; n < 2; ++n) { float* p = rp + bj * HALF + n * 16; const f32x4 v = acc[0][bj][m][n];
                            unsafeAtomicAdd(p, v.x); unsafeAtomicAdd(p + 1, v.y); unsafeAtomicAdd(p + 2, v.z); unsafeAtomicAdd(p + 3, v.w); } } }
            return;
        }
#pragma unroll
        for (int ai = 0; ai < 2; ++ai) {
            u32x2 xv[4][2][2];
#pragma unroll
            for (int m = 0; m < 4; ++m) { const bf16_t* bp = XB + (size_t)(u.pm * BM + ai * HALF + wr * 64 + m * 16 + fr) * DM + col0;
#pragma unroll
                for (int bj = 0; bj < 2; ++bj)
#pragma unroll
                    for (int n = 0; n < 2; ++n) xv[m][bj][n] = *(const u32x2*)(bp + bj * HALF + n * 16); }
#pragma unroll
            for (int m = 0; m < 4; ++m) { const int row = u.pm * BM + ai * HALF + wr * 64 + m * 16 + fr;
                float ss = 0.f;
                float* rp = X + (size_t)row * DM + col0; bf16_t* bp = XB + (size_t)row * DM + col0;
#pragma unroll
                for (int bj = 0; bj < 2; ++bj)
#pragma unroll
                    for (int n = 0; n < 2; ++n) { const u32x2 xw = xv[m][bj][n];
                        const f32x4 v = (f32x4){bflo(xw.x), bfhi(xw.x), bflo(xw.y), bfhi(xw.y)} + acc[ai][bj][m][n];
                        if (final_f32) *(f32x4*)(rp + bj * HALF + n * 16) = v;
                        else { ss += (v.x * v.x + v.y * v.y) + (v.z * v.z + v.w * v.w);
                            u32x2 w; w.x = pk2(v.x, v.y); w.y = pk2(v.z, v.w); *(u32x2*)(bp + bj * HALF + n * 16) = w; } }
                if (!final_f32) { const int ln = fr + 16 * fq; ss += shx(ss, 16, ln); ss += shx(ss, 32, ln);
                    if (fq == 0) SSn[(size_t)row * 16 + u.pn * 4 + wc] = ss; } }
        }
    }
};

struct EpiFfnUp {
    static constexpr bool PERM = true;
    int layer;
    __device__ __forceinline__ void operator()(f32x4 (&acc)[2][2][4][2], const Unit& u, int wr, int wc, int, int, LAS unsigned char* lds) const {
        const int ln_ = fresh_lane(), fr = ln_ & 15, fq = ln_ >> 4;
        unsigned char* ws_ = ARG_WS;
        const float* SS = (const float*)(ws_ + WS_RS);
        const int chl = wc * 32 + 8 * fq;
        const int ch0 = u.pn * 128 + chl;
        float rsv[2][4];
#pragma unroll
        for (int ai = 0; ai < 2; ++ai)
#pragma unroll
            for (int m = 0; m < 4; ++m) rsv[ai][m] = SS[u.pm * BM + ai * HALF + wr * 64 + m * 16 + fr];
        if (u.pm == 256) {
            float* T = (float*)(ws_ + WS_TMPS);
#pragma unroll
            for (int m = 0; m < 4; ++m) { float* tp = T + (size_t)(wr * 64 + m * 16 + fr) * (2 * FF) + ch0; const float rs = rsv[0][m];
#pragma unroll
                for (int n = 0; n < 2; ++n) { *(f32x4*)(tp + 4 * n) = acc[0][0][m][n] * rs; *(f32x4*)(tp + FF + 4 * n) = acc[0][1][m][n] * rs; } }
            return;
        }
        LAS float* halo = (LAS float*)(lds + STAGE_BYTES);
        bf16_t* H = (bf16_t*)(ws_ + WS_PROJ); float* THA = (float*)(ws_ + WS_THA); float* THG = (float*)(ws_ + WS_THG);
        const float* cw = argp(26); const float* cb = argp(27); float* out_p = ARG_OUT + O_PFF;
#pragma unroll
        for (int ai = 0; ai < 2; ++ai)
#pragma unroll
            for (int m = 0; m < 4; ++m) { const float rs = rsv[ai][m];
                acc[ai][0][m][0] *= rs; acc[ai][0][m][1] *= rs; acc[ai][1][m][0] *= rs; acc[ai][1][m][1] *= rs; }
        if (fr >= 14) {
#pragma unroll
            for (int ai = 0; ai < 2; ++ai)
#pragma unroll
                for (int m = 0; m < 4; ++m) { const int bi = 8 * ai + 4 * wr + m; int fo = 0; asm volatile("" : "+v"(fo) :: "memory");
#pragma unroll
                    for (int n = 0; n < 2; ++n) *(LAS f32x4*)(halo + fo + (bi * 2 + (fr - 14)) * 128 + chl + 4 * n) = acc[ai][0][m][n]; }
        }
        asm volatile("s_waitcnt lgkmcnt(0)\n\ts_barrier" ::: "memory");
        const bool seqstart = (u.pm & 7) == 0;
#pragma unroll
        for (int n = 0; n < 2; ++n) {
            asm volatile("" ::: "memory");
            const float* wp = cw + (size_t)layer * 3 * FF + ch0 + 4 * n;
            const f32x4 w0 = *(const f32x4*)wp, w1 = *(const f32x4*)(wp + FF), w2 = *(const f32x4*)(wp + 2 * FF), bb = *(const f32x4*)(cb + (size_t)layer * FF + ch0 + 4 * n);
            asm volatile("" :: "v"(w0), "v"(w1), "v"(w2), "v"(bb));
#pragma unroll
            for (int ai = 0; ai < 2; ++ai)
#pragma unroll
                for (int m = 0; m < 4; ++m) {
                    int fo = 0; asm volatile("" : "+v"(fo) :: "memory");
                    const int bi = 8 * ai + 4 * wr + m, rl = 16 * bi + fr + fo, row = u.pm * BM + rl;
                    const f32x4 cur = acc[ai][0][m][n], gv = acc[ai][1][m][n];
                    f32x4 p1, p2;
                    p1.x = dpp_shr<1>(cur.x); p1.y = dpp_shr<1>(cur.y); p1.z = dpp_shr<1>(cur.z); p1.w = dpp_shr<1>(cur.w);
                    p2.x = dpp_shr<2>(cur.x); p2.y = dpp_shr<2>(cur.y); p2.z = dpp_shr<2>(cur.z); p2.w = dpp_shr<2>(cur.w);
                    bool defer = false;
                    if (fr < 2) {
                        f32x4 e1 = (f32x4){0.f, 0.f, 0.f, 0.f}, e2 = e1;
                        if (bi > 0) { LAS float* hp = halo + fo + chl + 4 * n; e2 = *(LAS f32x4*)(hp + ((bi - 1) * 2 + 0) * 128); e1 = *(LAS f32x4*)(hp + ((bi - 1) * 2 + 1) * 128); }
                        else defer = !seqstart;
                        if (fr == 0) { p1 = e1; p2 = e2; } else { p2 = e1; }
                        if (defer) { *(f32x4*)(THA + ((size_t)u.pm * 4 + 2 + fr) * FF + ch0 + 4 * n) = cur; *(f32x4*)(THG + ((size_t)u.pm * 2 + fr) * FF + ch0 + 4 * n) = gv; }
                    }
                    if (fr >= 14 && bi == 15) {
                        *(f32x4*)(THA + ((size_t)u.pm * 4 + (fr - 14)) * FF + ch0 + 4 * n) = cur;
                        if ((u.pm & 7) == 7) *(f32x4*)(out_p + ((size_t)(layer * NBATCH + (u.pm >> 3)) * 2 + (fr - 14)) * FF + ch0 + 4 * n) = cur;
                    }
                    const f32x4 y = bb + w0 * p2 + w1 * p1 + w2 * cur;
                    u32x2 hw; hw.x = pk2(siluf_(y.x) * gv.x, siluf_(y.y) * gv.y); hw.y = pk2(siluf_(y.z) * gv.z, siluf_(y.w) * gv.w);
                    if (!defer) *(u32x2*)(H + (size_t)row * FF + ch0 + 4 * n) = hw;
                }
        }
    }
};

template <class Epi>
__device__ __forceinline__ void gemm_phase(LAS unsigned char* lds, const Gemm g, const StaticOrder& S, const Epi& E, int wv0) {
    const int tid = ltid(wv0), wid = __builtin_amdgcn_readfirstlane(tid >> 6), lane = tid & 63, wr = wid >> 2, wc = wid & 3, fr = lane & 15, fq = lane >> 4;
    const int K = g.K, lda = g.lda;
    unsigned voffA[2], voffB[2];
#pragma unroll
    for (int i = 0; i < 2; ++i) { int R, C; stage_rc(tid * 16 + i * 8192, R, C); const int Rb = Epi::PERM ? ((R & ~31) + perm32(R & 31)) : R;
        voffA[i] = (unsigned)(R * lda + C) * 2u; voffB[i] = (unsigned)(Rb * K + C) * 2u; }
    constexpr unsigned kstep = BK * 2;
    const unsigned hsA = (unsigned)HALF * lda * 2u, hsB = (unsigned)HALF * K * 2u;
    const unsigned tsA = 2u * hsA, tsB = 2u * hsB;
    const unsigned ldsw = (unsigned)wid * 1024u;
    const int aoff = lds_byte(wr * 64 + fr, fq * 8), boff = lds_byte(wc * 32 + fr, fq * 8);
#define PG8_SA(b, h) (((b) * 2 + (h)) * HTB)
#define PG8_SB(b, h) ((4 + (b) * 2 + (h)) * HTB)
#define PG8_STAGE(bufoff, gbase, voff) do { _Pragma("unroll") for (int _i = 0; _i < 2; ++_i) \
        __builtin_amdgcn_global_load_lds((const unsigned*)((const char*)(gbase) + (voff)[_i]), (LAS unsigned*)(lds + (bufoff) + ldsw + _i * 8192), 16, 0, 0); } while (0)
#define PG8_LDA(dst, b, h) do { _Pragma("unroll") for (int m = 0; m < 4; ++m) _Pragma("unroll") for (int k = 0; k < 2; ++k) dst[m][k] = *(const LAS bf16x8*)(lds + PG8_SA(b, h) + aoff + m * 2048 + k * 1024); } while (0)
#define PG8_LDB(dst, b, h) do { _Pragma("unroll") for (int n = 0; n < 2; ++n) _Pragma("unroll") for (int k = 0; k < 2; ++k) dst[n][k] = *(const LAS bf16x8*)(lds + PG8_SB(b, h) + boff + n * 2048 + k * 1024); } while (0)
#define PG8_MMA(ai, bj, At, Bt) do { __builtin_amdgcn_s_setprio(1); _Pragma("unroll") for (int m = 0; m < 4; ++m) _Pragma("unroll") for (int n = 0; n < 2; ++n) _Pragma("unroll") for (int k = 0; k < 2; ++k) \
        acc[ai][bj][m][n] = __builtin_amdgcn_mfma_f32_16x16x32_bf16(Bt[n][k], At[m][k], acc[ai][bj][m][n], 0, 0, 0); __builtin_amdgcn_s_setprio(0); } while (0)
#define PG8_WAIT_V(n) asm volatile("s_waitcnt vmcnt(" #n ")" ::: "memory")
#define PG8_WAIT_L(n) asm volatile("s_waitcnt lgkmcnt(" #n ")" ::: "memory")
#define PG8_BAR __builtin_amdgcn_s_barrier()
#define PG8_SCHED __builtin_amdgcn_sched_barrier(0)
    Unit cur, nxt; int ui = 0;
    if (!S.next(0, cur)) return;
    f32x4 acc[2][2][4][2];
#pragma unroll
    for (int a = 0; a < 2; ++a)
#pragma unroll
        for (int b = 0; b < 2; ++b)
#pragma unroll
            for (int m = 0; m < 4; ++m)
#pragma unroll
                for (int n = 0; n < 2; ++n) acc[a][b][m][n] = (f32x4){0.f, 0.f, 0.f, 0.f};
    bf16x8 At[4][2], B0[2][2], B1[2][2];
    const char* cA = (const char*)g.A + ((unsigned)cur.pm * tsA + (unsigned)cur.kt0 * kstep); const char* cB = (const char*)g.Bt + ((unsigned)cur.pn * tsB + (unsigned)cur.kt0 * kstep);
    PG8_STAGE(PG8_SB(0, 0), cB, voffB); PG8_STAGE(PG8_SB(0, 1), cB + hsB, voffB); PG8_STAGE(PG8_SA(0, 0), cA, voffA); PG8_STAGE(PG8_SA(0, 1), cA + hsA, voffA);
    if (wr == 1) PG8_BAR;
    PG8_WAIT_V(2); PG8_BAR;
    PG8_STAGE(PG8_SB(1, 0), cB + kstep, voffB); PG8_STAGE(PG8_SA(1, 0), cA + kstep, voffA); PG8_STAGE(PG8_SB(1, 1), cB + hsB + kstep, voffB);
    PG8_WAIT_V(6); PG8_BAR;
    for (;;) {
        const bool has_next = S.next(ui + 1, nxt);
        const char* nA = has_next ? (const char*)g.A + ((unsigned)nxt.pm * tsA + (unsigned)nxt.kt0 * kstep) : cA; const char* nB = has_next ? (const char*)g.Bt + ((unsigned)nxt.pn * tsB + (unsigned)nxt.kt0 * kstep) : cB;
        const int nt = cur.nkt;
        for (int t = 0; t < nt; t += 2) {
            const bool last = (t == nt - 2);
            const char* a1 = cA + (unsigned)(t + 1) * kstep;
            const char* a2 = last ? nA : cA + (unsigned)(t + 2) * kstep; const char* b2 = last ? nB : cB + (unsigned)(t + 2) * kstep;
            const char* a3 = a2 + kstep; const char* b3 = b2 + kstep;
            PG8_LDB(B0, 0, 0); PG8_LDB(B1, 0, 1); PG8_SCHED; PG8_LDA(At, 0, 0); PG8_STAGE(PG8_SA(1, 1), a1 + hsA, voffA);
            PG8_WAIT_V(8); PG8_WAIT_L(0); PG8_BAR; PG8_MMA(0, 0, At, B0); PG8_MMA(0, 1, At, B1); PG8_BAR; PG8_SCHED;
            PG8_LDA(At, 0, 1); PG8_STAGE(PG8_SB(0, 0), b2, voffB); PG8_STAGE(PG8_SB(0, 1), b2 + hsB, voffB); PG8_STAGE(PG8_SA(0, 0), a2, voffA);
            PG8_WAIT_V(8); PG8_WAIT_L(0); PG8_BAR; PG8_MMA(1, 0, At, B0); PG8_MMA(1, 1, At, B1); PG8_BAR; PG8_SCHED;
            PG8_LDB(B0, 1, 0); PG8_LDB(B1, 1, 1); PG8_SCHED; PG8_LDA(At, 1, 0); PG8_STAGE(PG8_SA(0, 1), a2 + hsA, voffA);
            PG8_WAIT_V(8); PG8_WAIT_L(0); PG8_BAR; PG8_MMA(0, 0, At, B0); PG8_MMA(0, 1, At, B1); PG8_BAR; PG8_SCHED;
            PG8_LDA(At, 1, 1); PG8_STAGE(PG8_SB(1, 0), b3, voffB); PG8_STAGE(PG8_SB(1, 1), b3 + hsB, voffB); PG8_STAGE(PG8_SA(1, 0), a3, voffA);
            PG8_WAIT_V(8); PG8_WAIT_L(0); PG8_BAR; PG8_MMA(1, 0, At, B0); PG8_MMA(1, 1, At, B1); PG8_BAR; PG8_SCHED;
        }
        if (wr == 0) PG8_BAR;
        E(acc, cur, wr, wc, fr, fq, lds);
        if (!has_next) break;
#pragma unroll
        for (int a = 0; a < 2; ++a)
#pragma unroll
            for (int b = 0; b < 2; ++b)
#pragma unroll
                for (int m = 0; m < 4; ++m)
#pragma unroll
                    for (int n = 0; n < 2; ++n) acc[a][b][m][n] = (f32x4){0.f, 0.f, 0.f, 0.f};
        cur = nxt; cA = nA; cB = nB; ++ui;
        if (wr == 1) PG8_BAR;
    }
    PG8_WAIT_V(0);
    PG8_BAR;
#undef PG8_SA
#undef PG8_SB
#undef PG8_STAGE
#undef PG8_LDA
#undef PG8_LDB
#undef PG8_MMA
#undef PG8_WAIT_V
#undef PG8_WAIT_L
#undef PG8_BAR
#undef PG8_SCHED
}
}

__device__ __forceinline__ void transpose_item(const float* W, int K, int N, int Nvalid, bf16_t* WT, int kb, int nb, int evenperm, const float* gain, LAS float* scr, int lane) {
    const int k0 = 64 * kb, n0 = 32 * nb;
    int ns0 = n0;
    if (evenperm == 1) { if (n0 < 512) ns0 = n0 + 1024; else if (n0 >= 1024 && n0 < 1536) ns0 = n0 - 1024; }
    else if (evenperm == 2) { const int blk = n0 >> 8, r = n0 & 255; ns0 = (r < 128) ? 128 * blk + r : FF + 128 * blk + (r - 128); }
    const int nn = lane & 31; const bool ok = (n0 + nn) < Nvalid;
#pragma unroll 8
    for (int i = 0; i < 32; ++i) { const int kk = 2 * i + (lane >> 5); const float gk = gain ? gain[k0 + kk] : 1.f; scr[kk * 33 + nn] = ok ? W[(size_t)(k0 + kk) * N + ns0 + nn] * gk : 0.f; }
    LDS_WAIT(); asm volatile("" ::: "memory");
    const int c = lane & 7;
#pragma unroll
    for (int j = 0; j < 4; ++j) { const int n = (lane >> 3) + 8 * j; const LAS float* s = scr + (8 * c) * 33 + n;
        u32x4 o; o.x = pk2(s[0 * 33], s[1 * 33]); o.y = pk2(s[2 * 33], s[3 * 33]); o.z = pk2(s[4 * 33], s[5 * 33]); o.w = pk2(s[6 * 33], s[7 * 33]);
        *(u32x4*)(WT + (size_t)(n0 + n) * K + k0 + 8 * c) = o; }
    LDS_WAIT(); asm volatile("" ::: "memory");
}

__device__ __forceinline__ bool transpose_family(int& it, const float* src, bf16_t* dst, int nl, int K, int N, int Npad, int evenperm, const float* gain, int gstride, int goff, LAS float* scr, int lane) {
    const int nblk = Npad / 32, per = (K / 64) * nblk, tot = nl * per;
    if (it >= tot) { it -= tot; return false; }
    const int l = it / per, r = it % per;
    transpose_item(src + (size_t)l * K * N, K, N, N, dst + (size_t)l * Npad * K, r / nblk, r % nblk, evenperm, gain ? gain + (size_t)(l * gstride + goff) * DM : nullptr, scr, lane);
    return true;
}

__device__ __forceinline__ void cast_row(const float* xrow, bf16_t* orow, float* copyrow, float* ssp, int lane) {
    const f32x4* xr = (const f32x4*)xrow + lane;
    f32x4 v[4]; float s = 0.f;
#pragma unroll
    for (int j = 0; j < 4; ++j) { v[j] = xr[64 * j]; s += (v[j].x * v[j].x + v[j].y * v[j].y) + (v[j].z * v[j].z + v[j].w * v[j].w); }
    s = wave_sum(s, lane);
    unsigned long long* o8 = (unsigned long long*)orow + lane;
#pragma unroll
    for (int j = 0; j < 4; ++j) {
        o8[64 * j] = (unsigned long long)pk2(v[j].x, v[j].y) | ((unsigned long long)pk2(v[j].z, v[j].w) << 32);
        if (copyrow) ((f32x4*)copyrow + lane)[64 * j] = v[j];
    }
    if (lane == 0) *ssp = frsq((s + EPS * DM) * (1.f / DM));
}

__device__ __forceinline__ void unpack8(const u32x4 w, float (&f)[8]) {
    f[0] = bflo(w.x); f[1] = bfhi(w.x); f[2] = bflo(w.y); f[3] = bfhi(w.y); f[4] = bflo(w.z); f[5] = bfhi(w.z); f[6] = bflo(w.w); f[7] = bfhi(w.w);
}
__device__ __forceinline__ u32x4 pack8(const float (&f)[8]) { u32x4 w; w.x = pk2(f[0], f[1]); w.y = pk2(f[2], f[3]); w.z = pk2(f[4], f[5]); w.w = pk2(f[6], f[7]); return w; }

__device__ __forceinline__ void even_prep_row(int m, int j, bf16_t* PROJ, float* out, const float* state_sconv, const float* conv_w, const float* qg, const float* kg, const float* bfg,
                                              bf16_t* KS, bf16_t* VS, int lane) {
    int b, t, L; bool isS;
    if (m < MP) { b = m >> 11; t = m & 2047; L = SEQ; isS = false; } else { const int mm = m - MP; b = mm >> 4; t = mm & 15; L = DSEQ; isS = true; }
    bf16_t* P = PROJ + (size_t)m * EINP;
    const int c0 = lane * 8;
    const u32x4 gbw = *(const u32x4*)(P + 1024 + c0), qw = *(const u32x4*)(P + 1536 + c0), kw = *(const u32x4*)(P + 2048 + c0), vw = *(const u32x4*)(P + 2560 + c0);
    const unsigned short fw = (lane < 8) ? P[3072 + lane] : (unsigned short)0;
    float cu[3][8];
#pragma unroll
    for (int d = 0; d < 3; ++d) {
        const int tau = t - 2 + d;
        if (tau >= 0) {
            const bf16_t* Pr = PROJ + (size_t)(m - 2 + d) * EINP;
            float u[8], gc[8]; unpack8(*(const u32x4*)(Pr + c0), u); unpack8(*(const u32x4*)(Pr + 512 + c0), gc);
#pragma unroll
            for (int e = 0; e < 8; ++e) cu[d][e] = gc[e] * u[e];
        } else if (isS) {
            const float* sp = state_sconv + ((size_t)(j * DBATCH + b) * 2 + (tau + 2)) * 512 + c0;
            const f32x4 a = *(const f32x4*)sp, c = *(const f32x4*)(sp + 4);
            cu[d][0] = a.x; cu[d][1] = a.y; cu[d][2] = a.z; cu[d][3] = a.w; cu[d][4] = c.x; cu[d][5] = c.y; cu[d][6] = c.z; cu[d][7] = c.w;
        } else {
#pragma unroll
            for (int e = 0; e < 8; ++e) cu[d][e] = 0.f;
        }
    }
    {
        float gb[8]; unpack8(gbw, gb);
        const float* w = conv_w + (size_t)j * 3 * 512 + c0;
        float o[8];
#pragma unroll
        for (int e = 0; e < 8; ++e) o[e] = gb[e] * (w[e] * cu[0][e] + w[512 + e] * cu[1][e] + w[1024 + e] * cu[2][e]);
        *(u32x4*)(P + 1024 + c0) = pack8(o);
        if (t >= L - 2) {
            float* sp = out + (isS ? O_SSC + ((size_t)(j * DBATCH + b) * 2 + (t - (L - 2))) * 512 : O_PSC + ((size_t)(j * NBATCH + b) * 2 + (t - (L - 2))) * 512) + c0;
            *(f32x4*)sp = (f32x4){cu[2][0], cu[2][1], cu[2][2], cu[2][3]}; *(f32x4*)(sp + 4) = (f32x4){cu[2][4], cu[2][5], cu[2][6], cu[2][7]};
        }
    }
    const int d0 = (lane & 7) * 8;
    {
        float q[8]; unpack8(qw, q);
        float ss = 0.f;
#pragma unroll
        for (int e = 0; e < 8; ++e) ss += q[e] * q[e];
        ss += shx(ss, 1, lane); ss += shx(ss, 2, lane); ss += shx(ss, 4, lane);
        const float r = frsq((ss + EPS * 64.f) * (1.f / 64.f)) * (0.125f * LOG2E);
        const float* gq = qg + j * 64 + d0;
#pragma unroll
        for (int e = 0; e < 8; ++e) q[e] = q[e] * r * gq[e];
        *(u32x4*)(P + 1536 + c0) = pack8(q);
    }
    {
        float k[8]; unpack8(kw, k);
        float ss = 0.f;
#pragma unroll
        for (int e = 0; e < 8; ++e) ss += k[e] * k[e];
        ss += shx(ss, 1, lane); ss += shx(ss, 2, lane); ss += shx(ss, 4, lane);
        const float r = frsq((ss + EPS * 64.f) * (1.f / 64.f));
        const float* gk = kg + j * 64 + d0;
#pragma unroll
        for (int e = 0; e < 8; ++e) k[e] = k[e] * r * gk[e];
        const u32x4 kb = pack8(k);
        *(u32x4*)(P + 2048 + c0) = kb;
        float* op = out + (isS ? O_SK + ((size_t)(j * DBATCH + b) * DSEQ + t) * 512 : O_PK + ((size_t)(j * NBATCH + b) * SEQ + t) * 512) + c0;
        *(f32x4*)op = (f32x4){k[0], k[1], k[2], k[3]}; *(f32x4*)(op + 4) = (f32x4){k[4], k[5], k[6], k[7]};
        if (isS) *(u32x4*)(KS + ((size_t)b * KSROWS + PAST + t) * 512 + c0) = kb;
    }
    {
        const u32x4 vb = vw;
        float v[8]; unpack8(vb, v);
        float* op = out + (isS ? O_SV + ((size_t)(j * DBATCH + b) * DSEQ + t) * 512 : O_PV + ((size_t)(j * NBATCH + b) * SEQ + t) * 512) + c0;
        *(f32x4*)op = (f32x4){v[0], v[1], v[2], v[3]}; *(f32x4*)(op + 4) = (f32x4){v[4], v[5], v[6], v[7]};
        if (isS) *(u32x4*)(VS + ((size_t)b * KSROWS + PAST + t) * 512 + c0) = vb;
    }
    if (lane < 8) {
        const float f = bf2f(fw) + bfg[j * 8 + lane];
        const float lf = fminf(f, 0.f) - log1pexp_neg(fabsf(f));
        out[(isS ? O_SLF + ((size_t)(j * DBATCH + b) * DSEQ + t) * 8 : O_PLF + ((size_t)(j * NBATCH + b) * SEQ + t) * 8) + lane] = lf;
    }
}

constexpr int AT_KB = 9216, AT_VB = 8192;
constexpr int AT_K0 = 0, AT_V0 = 2 * AT_KB, AT_CUM = AT_V0 + 2 * AT_VB, AT_WS = AT_CUM + 2112 * 4, AT_END = AT_WS + 64;
__device__ __forceinline__ s16x4 vtr(LAS unsigned char* p) { typedef short v4i16_t __attribute__((ext_vector_type(4))); return __builtin_bit_cast(s16x4, __builtin_amdgcn_ds_read_tr16_b64_v4i16((LAS v4i16_t*)p)); }

__device__ __forceinline__ void attn_unit(LAS unsigned char* lds, bf16_t* Q, int qpitch, const bf16_t* K, const bf16_t* V, int kvpitch, int nq, int qpos0, int nkeys,
                                          const float* lf_past, int npast, const float* lf_new, int nact, int wv0, bool reuse_cum) {
    const int tid = ltid(wv0), lane = tid & 63, wave = __builtin_amdgcn_readfirstlane(tid >> 6), r32 = lane & 31, hi = lane >> 5;
    const int NT = (nkeys + 63) >> 6;
    LAS float* cum2 = (LAS float*)(lds + AT_CUM); LAS float* wsum = (LAS float*)(lds + AT_WS);
    __syncthreads();
    if (!reuse_cum) {
        float v[4];
#pragma unroll
        for (int e = 0; e < 4; ++e) { const int i = 4 * tid + e; v[e] = (i < nkeys) ? (i < npast ? lf_past[(size_t)i * 8] : lf_new[(size_t)(i - npast) * 8]) : 0.f; }
        v[1] += v[0]; v[2] += v[1]; v[3] += v[2];
        const float tot = v[3]; float sc = tot;
#pragma unroll
        for (int o = 1; o < 64; o <<= 1) { const float tt = shup(sc, o, lane); if (lane >= o) sc += tt; }
        if (lane == 63) wsum[wave] = sc;
        __syncthreads();
        float woff = 0.f;
        for (int w = 0; w < wave; ++w) woff += wsum[w];
        const float base = woff + sc - tot;
        *(LAS f32x4*)(cum2 + 4 * tid) = (f32x4){(base + v[0]) * -LOG2E, (base + v[1]) * -LOG2E, (base + v[2]) * -LOG2E, (base + v[3]) * -LOG2E};
    }
    const int srow = tid >> 3, sch = tid & 7;
    const bf16_t* kg = K + (size_t)srow * kvpitch + sch * 8; const bf16_t* vg = V + (size_t)srow * kvpitch + sch * 8;
    const int kdst = srow * 144 + sch * 16, vdst = (sch >> 2) * 4096 + srow * 64 + (sch & 3) * 16;
    u32x4 kreg = *(const u32x4*)(kg + (size_t)(NT - 1) * 64 * kvpitch), vreg = *(const u32x4*)(vg + (size_t)(NT - 1) * 64 * kvpitch);
    *(LAS u32x4*)(lds + AT_K0 + kdst) = kreg; *(LAS u32x4*)(lds + AT_V0 + vdst) = vreg;
    if (NT > 1) { kreg = *(const u32x4*)(kg + (size_t)(NT - 2) * 64 * kvpitch); vreg = *(const u32x4*)(vg + (size_t)(NT - 2) * 64 * kvpitch); }
    const int qrow = wave * 32 + r32;
    const bool wact = wave < nact;
    bf16x8 qr[4];
    { const bf16_t* qp = Q + (size_t)(wact ? qrow : 0) * qpitch;
#pragma unroll
      for (int s = 0; s < 4; ++s) qr[s] = *(const bf16x8*)(qp + 16 * s + 8 * hi); }
    const int qpos = qpos0 + qrow;
    __syncthreads();
    float m_run = -1e30f, l_run = 0.f; f32x16 o[2]; o[0] = f32x16{}; o[1] = f32x16{};
    const int vbase = ((lane & 15) >> 2) * 64 + ((lane >> 4) & 1) * 32 + (lane & 3) * 8 + hi * 256;
    for (int it = 0; it < NT; ++it) {
        const int kt = NT - 1 - it;
        LAS unsigned char* Kb = lds + AT_K0 + (it & 1) * AT_KB; LAS unsigned char* Vb = lds + AT_V0 + (it & 1) * AT_VB;
        if (wact && 64 * kt <= qpos0 + wave * 32 + 31) {
            f32x16 p[2];
#pragma unroll
            for (int kb = 0; kb < 2; ++kb)
#pragma unroll
                for (int g4 = 0; g4 < 4; ++g4) { const f32x4 cv = *(LAS f32x4*)(cum2 + 64 * kt + 32 * kb + 8 * g4 + 4 * hi);
                    p[kb][4 * g4 + 0] = cv.x; p[kb][4 * g4 + 1] = cv.y; p[kb][4 * g4 + 2] = cv.z; p[kb][4 * g4 + 3] = cv.w; }
#pragma unroll
            for (int kb = 0; kb < 2; ++kb)
#pragma unroll
                for (int s = 0; s < 4; ++s) { const bf16x8 a = *(LAS bf16x8*)(Kb + (32 * kb + r32) * 144 + (16 * s + 8 * hi) * 2);
                    p[kb] = __builtin_amdgcn_mfma_f32_32x32x16_bf16(a, qr[s], p[kb], 0, 0, 0); }
            if (64 * kt + 63 > qpos0 + wave * 32) {
                float ninf = -INFINITY; asm volatile("" : "+v"(ninf));
#pragma unroll
                for (int kb = 0; kb < 2; ++kb)
#pragma unroll
                    for (int r = 0; r < 16; ++r) { const int key = 64 * kt + 32 * kb + crow(r, hi); if (key > qpos) p[kb][r] = ninf; }
            }
            float rm = p[0][0];
#pragma unroll
            for (int r = 1; r < 16; ++r) rm = fmaxf(rm, p[0][r]);
#pragma unroll
            for (int r = 0; r < 16; ++r) rm = fmaxf(rm, p[1][r]);
            rm = fmaxf(rm, shx(rm, 32, lane));
            const float mnew = fmaxf(m_run, rm);
            if (__builtin_amdgcn_ballot_w64(rm > m_run) != 0ull) {
                const float fsc = fexp2(m_run - mnew);
                l_run *= fsc;
#pragma unroll
                for (int r = 0; r < 16; ++r) { o[0][r] *= fsc; o[1][r] *= fsc; }
            }
            m_run = mnew;
            float ls = 0.f;
#pragma unroll
            for (int kb = 0; kb < 2; ++kb)
#pragma unroll
                for (int r = 0; r < 16; ++r) { p[kb][r] = fexp2(p[kb][r] - mnew); ls += p[kb][r]; }
            l_run += ls;
#pragma unroll
            for (int kb = 0; kb < 2; ++kb)
#pragma unroll
                for (int s = 0; s < 2; ++s) {
                    u32x4 pw; pw.x = pk2(p[kb][8 * s + 0], p[kb][8 * s + 1]); pw.y = pk2(p[kb][8 * s + 2], p[kb][8 * s + 3]); pw.z = pk2(p[kb][8 * s + 4], p[kb][8 * s + 5]); pw.w = pk2(p[kb][8 * s + 6], p[kb][8 * s + 7]);
                    const bf16x8 pf = __builtin_bit_cast(bf16x8, pw);
#pragma unroll
                    for (int db = 0; db < 2; ++db) {
                        LAS unsigned char* vp = Vb + db * 4096 + (32 * kb + 16 * s) * 64 + vbase;
                        const s16x4 lo = vtr(vp), h2 = vtr(vp + 512);
                        const bf16x8 vf = (bf16x8){lo[0], lo[1], lo[2], lo[3], h2[0], h2[1], h2[2], h2[3]};
                        o[db] = __builtin_amdgcn_mfma_f32_32x32x16_bf16(vf, pf, o[db], 0, 0, 0);
                    }
                }
        }
        if (it + 1 < NT) {
            LAS unsigned char* Kn = lds + AT_K0 + ((it + 1) & 1) * AT_KB; LAS unsigned char* Vn = lds + AT_V0 + ((it + 1) & 1) * AT_VB;
            *(LAS u32x4*)(Kn + kdst) = kreg; *(LAS u32x4*)(Vn + vdst) = vreg;
            if (it + 2 < NT) { kreg = *(const u32x4*)(kg + (size_t)(kt - 2) * 64 * kvpitch); vreg = *(const u32x4*)(vg + (size_t)(kt - 2) * 64 * kvpitch); }
        }
        __syncthreads();
    }
    l_run += shx(l_run, 32, lane);
    if (wact && qrow < nq) {
        const float rl = 1.0f / l_run;
        bf16_t* op = Q + (size_t)qrow * qpitch;
#pragma unroll
        for (int db = 0; db < 2; ++db)
#pragma unroll
            for (int g4 = 0; g4 < 4; ++g4) {
                u32x2 w; w.x = pk2(o[db][4 * g4 + 0] * rl, o[db][4 * g4 + 1] * rl); w.y = pk2(o[db][4 * g4 + 2] * rl, o[db][4 * g4 + 3] * rl);
                *(u32x2*)(op + 32 * db + 8 * g4 + 4 * hi) = w;
            }
    }
}

__device__ __forceinline__ void ffn_act_row(int m, int layer, bf16_t* PROJ, float* out, const float* st_ffn, const float* cw, const float* cb, int lane) {
    int b, t, L; bool isS;
    if (m < MP) { b = m >> 11; t = m & 2047; L = SEQ; isS = false; } else { const int mm = m - MP; b = mm >> 4; t = mm & 15; L = DSEQ; isS = true; }
    bf16_t* P = PROJ + (size_t)m * FF2;
    for (int oc = lane; oc < FF / 8; oc += 64) {
        const int c0 = oc * 8;
        float a[3][8];
#pragma unroll
        for (int d = 0; d < 3; ++d) {
            const int tau = t - 2 + d;
            if (tau >= 0) { unpack8(*(const u32x4*)(PROJ + (size_t)(m - 2 + d) * FF2 + c0), a[d]); }
            else if (isS) { const float* sp = st_ffn + ((size_t)(layer * DBATCH + b) * 2 + (tau + 2)) * FF + c0; const f32x4 x = *(const f32x4*)sp, y = *(const f32x4*)(sp + 4);
                a[d][0] = x.x; a[d][1] = x.y; a[d][2] = x.z; a[d][3] = x.w; a[d][4] = y.x; a[d][5] = y.y; a[d][6] = y.z; a[d][7] = y.w; }
            else {
#pragma unroll
                for (int e = 0; e < 8; ++e) a[d][e] = 0.f; }
        }
        float gg[8]; unpack8(*(const u32x4*)(P + FF + c0), gg);
        const float* w = cw + (size_t)layer * 3 * FF + c0; const float* bb = cb + (size_t)layer * FF + c0;
        float o[8];
#pragma unroll
        for (int e = 0; e < 8; ++e) { const float y = bb[e] + w[e] * a[0][e] + w[FF + e] * a[1][e] + w[2 * FF + e] * a[2][e]; o[e] = siluf_(y) * gg[e]; }
        *(u32x4*)(P + FF + c0) = pack8(o);
        if (t >= L - 2) {
            float* sp = out + (isS ? O_SFF + ((size_t)(layer * DBATCH + b) * 2 + (t - (L - 2))) * FF : O_PFF + ((size_t)(layer * NBATCH + b) * 2 + (t - (L - 2))) * FF) + c0;
            *(f32x4*)sp = (f32x4){a[2][0], a[2][1], a[2][2], a[2][3]}; *(f32x4*)(sp + 4) = (f32x4){a[2][4], a[2][5], a[2][6], a[2][7]};
        }
    }
}

constexpr int SD_BUF = 65536, SD_X = 0, SD_B = 32768, SD_C = 49152, SD_DT = 131072, SD_CUM = 132096, SD_YST = 133120, SD_END = 149504;
#define IMG16(img, row, ec) ((img) + ((ec) >> 5) * 4096 + (row) * 64 + ((ec) & 31) * 2)
#define IMG8(img, row, ec) IMG16(img, row, ec)

__device__ __forceinline__ void ssd_mix(LAS unsigned char* Brow, LAS unsigned char* Crow, LAS unsigned char* cumh, LAS unsigned char* dth, int sb, int qm, float cq, bf16x8& m0, bf16x8& m1) {
    f32x16 G = f32x16{};
#pragma unroll
    for (int ks = 0; ks < 8; ++ks) {
        const bf16x8 af = *(LAS bf16x8*)(Brow + sb * 2048 + (ks >> 1) * 4096 + (ks & 1) * 32);
        const bf16x8 bfg = *(LAS bf16x8*)(Crow + (ks >> 1) * 4096 + (ks & 1) * 32);
        G = __builtin_amdgcn_mfma_f32_32x32x16_bf16(af, bfg, G, 0, 0, 0);
    }
#pragma unroll
    for (int g4 = 0; g4 < 4; ++g4) {
        const f32x4 cv = *(LAS f32x4*)(cumh + (32 * sb + 8 * g4) * 4), dv = *(LAS f32x4*)(dth + (32 * sb + 8 * g4) * 4);
#pragma unroll
        for (int e = 0; e < 4; ++e) { const float wgt = fexp(fminf(cq - cv[e], 0.f)) * dv[e]; G[4 * g4 + e] = ((32 * sb + 8 * g4 + e) <= qm) ? G[4 * g4 + e] * wgt : 0.f; }
    }
    u32x4 pw; pw.x = pk2(G[0], G[1]); pw.y = pk2(G[2], G[3]); pw.z = pk2(G[4], G[5]); pw.w = pk2(G[6], G[7]); m0 = __builtin_bit_cast(bf16x8, pw);
    pw.x = pk2(G[8], G[9]); pw.y = pk2(G[10], G[11]); pw.z = pk2(G[12], G[13]); pw.w = pk2(G[14], G[15]); m1 = __builtin_bit_cast(bf16x8, pw);
}

__device__ __forceinline__ void ssd_unit(LAS unsigned char* lds, int j, int b, int g, int half, bool isS, bf16_t* PROJ, float* out,
                                         const float* st_conv, const float* st_ssm, const float* cw, const float* cbias, const float* dtb_, const float* alog, const float* dsk, int wv0) {
    const int tid = ltid(wv0), lane = tid & 63, wave = __builtin_amdgcn_readfirstlane(tid >> 6), r32 = lane & 31, hi = lane >> 5;
    const int m0 = isS ? MP + DSEQ * b : b * SEQ, nchunks = isS ? 1 : SEQ / 64, nvalid = isS ? DSEQ : 64;
    __syncthreads();
    if (wave >= 4) {
        const int ptid = tid - 256, oct = ptid & 63, seg = ptid >> 6;
        int col, sdst;
        if (oct < 32) { col = 2048 + g * 512 + half * 256 + oct * 8; sdst = SD_X + ((oct >> 3) * 2 + ((oct & 7) >> 2)) * 4096 + (oct & 3) * 16; }
        else if (oct < 48) { const int n0 = (oct - 32) * 8; col = 4096 + g * 128 + n0; sdst = SD_B + (n0 >> 5) * 4096 + (n0 & 31) * 2; }
        else { const int n0 = (oct - 48) * 8; col = 4608 + g * 128 + n0; sdst = SD_C + (n0 >> 5) * 4096 + (n0 & 31) * 2; }
        const int ch = col - 2048;
        float w[4][8], bs[8];
#pragma unroll
        for (int k = 0; k < 4; ++k) { const float* wp = cw + ((size_t)j * 4 + k) * 3072 + ch; const f32x4 x = *(const f32x4*)wp, y = *(const f32x4*)(wp + 4);
            w[k][0] = x.x; w[k][1] = x.y; w[k][2] = x.z; w[k][3] = x.w; w[k][4] = y.x; w[k][5] = y.y; w[k][6] = y.z; w[k][7] = y.w; }
        { const float* bp = cbias + (size_t)j * 3072 + ch; const f32x4 x = *(const f32x4*)bp, y = *(const f32x4*)(bp + 4);
            bs[0] = x.x; bs[1] = x.y; bs[2] = x.z; bs[3] = x.w; bs[4] = y.x; bs[5] = y.y; bs[6] = y.z; bs[7] = y.w; }
        const int s0 = 16 * seg;
#pragma unroll 1
        for (int c = 0; c < nchunks; ++c) {
            const int t0 = c * 64;
            LAS unsigned char* dbase = lds + (c & 1) * SD_BUF + sdst;
            u32x4 rw[19];
#pragma unroll
            for (int d = 0; d < 19; ++d) {
                const int sl = s0 - 3 + d, tau = t0 + sl;
                if (tau >= 0) { rw[d] = (sl < nvalid) ? *(const u32x4*)(PROJ + (size_t)(m0 + tau) * OINP + col) : (u32x4){0u, 0u, 0u, 0u}; }
                else if (isS) { const float* sp = st_conv + ((size_t)(j * DBATCH + b) * 3 + (tau + 3)) * 3072 + ch; const f32x4 x = *(const f32x4*)sp, y = *(const f32x4*)(sp + 4);
                    rw[d].x = pk2(x.x, x.y); rw[d].y = pk2(x.z, x.w); rw[d].z = pk2(y.x, y.y); rw[d].w = pk2(y.z, y.w); }
                else rw[d] = (u32x4){0u, 0u, 0u, 0u};
            }
            float f0[8], f1[8], f2[8], f3[8];
            unpack8(rw[0], f0); unpack8(rw[1], f1); unpack8(rw[2], f2);
#pragma unroll
            for (int i = 0; i < 16; ++i) {
                const int s = s0 + i;
                float o[8];
                unpack8(rw[i + 3], f3);
#pragma unroll
                for (int e = 0; e < 8; ++e) { const float y = bs[e] + w[0][e] * f0[e] + w[1][e] * f1[e] + w[2][e] * f2[e] + w[3][e] * f3[e]; o[e] = (s < nvalid) ? siluf_(y) : 0.f; }
                *(LAS u32x4*)(dbase + s * 64) = pack8(o);
#pragma unroll
                for (int e = 0; e < 8; ++e) { f0[e] = f1[e]; f1[e] = f2[e]; f2[e] = f3[e]; }
            }
            __syncthreads();
        }
    } else {
        __builtin_amdgcn_s_setprio(2);
        const int hd = wave, h = 8 * g + 4 * half + hd;
        const float a_h = -fexp(alog[j * 32 + h]), dtb = dtb_[j * 32 + h], Dh = dsk[j * 32 + h];
        LAS float* dtv = (LAS float*)(lds + SD_DT) + hd * 64; LAS float* cumv = (LAS float*)(lds + SD_CUM) + hd * 64;
#define FRESH(x) int x = lane; asm volatile("" : "+v"(x))
#define O_RB(l) (((l) & 31) * 64 + ((l) >> 5) * 16)
#define O_RC(l) (((l) & 31) * 64 + ((l) >> 5) * 8)
#define O_TX(l) ((4 * ((l) >> 5) + (((l) & 15) >> 2)) * 64 + (((l) >> 4) & 1) * 32 + ((l) & 3) * 8)
#define O_T5(l) ((8 * ((l) >> 5) + (((l) & 15) >> 2)) * 64 + (((l) >> 4) & 1) * 32 + ((l) & 3) * 8)
#define O_YB(l) (((l) >> 5) * 512 + ((l) & 31) * 2)
#define O_G1(l) (((l) >> 3) * 128 + ((l) & 7) * 16)
#define O_G2(l) ((((l) & 7) >> 2) * 4096 + ((l) >> 3) * 64 + ((l) & 3) * 16)
#define O_H4(l) (((l) >> 5) * 16)
        f32x16 hT[4][2];
        const size_t st_off = ((size_t)((isS ? j * DBATCH : j * NBATCH) + b) * 32 + h) * 8192;
#pragma unroll
        for (int nb = 0; nb < 4; ++nb)
#pragma unroll
            for (int pb = 0; pb < 2; ++pb) {
                if (isS) {
                    const float* sp = st_ssm + st_off + (size_t)(32 * pb + r32) * 128 + 32 * nb + 4 * hi;
#pragma unroll
                    for (int g4 = 0; g4 < 4; ++g4) { const f32x4 v = *(const f32x4*)(sp + 8 * g4); hT[nb][pb][4 * g4] = v.x; hT[nb][pb][4 * g4 + 1] = v.y; hT[nb][pb][4 * g4 + 2] = v.z; hT[nb][pb][4 * g4 + 3] = v.w; }
                } else hT[nb][pb] = f32x16{};
            }
        LAS unsigned char* ystg = lds + SD_YST + hd * 4096;
        unsigned short dtr_next = (lane < nvalid) ? PROJ[(size_t)(m0 + lane) * OINP + 5120 + h] : (unsigned short)0;
#pragma unroll 1
        for (int c = 0; c < nchunks; ++c) {
            const int t0 = c * 64;
            LAS unsigned char* Xw = lds + (c & 1) * SD_BUF + SD_X + hd * 8192; LAS unsigned char* Bimg = lds + (c & 1) * SD_BUF + SD_B; LAS unsigned char* Cimg = lds + (c & 1) * SD_BUF + SD_C;
            {
                const bool valid = lane < nvalid;
                float dt = 0.f;
                const unsigned short dtr = dtr_next;
                if (c + 1 < nchunks) dtr_next = PROJ[(size_t)(m0 + t0 + 64 + lane) * OINP + 5120 + h];
                if (valid) dt = softplusf_(bf2f(dtr) + dtb);
                float cs = dt * a_h;
                int ln = lane; asm volatile("" : "+v"(ln));
#pragma unroll
                for (int o = 1; o < 64; o <<= 1) { const float tt = __builtin_bit_cast(float, __builtin_amdgcn_ds_bpermute((ln - o) << 2, __builtin_bit_cast(int, cs))); if (ln >= o) cs += tt; }
                dtv[lane] = dt; cumv[lane] = cs;
            }
            __syncthreads();
#pragma unroll 1
            for (int qb = 0; qb < 2; ++qb) {
                const int qrow = 32 * qb + r32;
                int qm = qrow - 4 * hi; asm volatile("" : "+v"(qm));
                const float cq = cumv[qrow];
#pragma unroll
                for (int nb = 0; nb < 4; ++nb) { asm volatile("" : "+v"(hT[nb][0])); asm volatile("" : "+v"(hT[nb][1])); }
                bf16x8 mixf[2][2];
                { FRESH(l1); LAS unsigned char* cumh = (LAS unsigned char*)cumv + O_H4(l1); LAS unsigned char* dth = (LAS unsigned char*)dtv + O_H4(l1);
                  ssd_mix(Bimg + O_RB(l1), Cimg + qb * 2048 + O_RB(l1), cumh, dth, 0, qm, cq, mixf[0][0], mixf[0][1]);
                  if (qb == 1) ssd_mix(Bimg + O_RB(l1), Cimg + qb * 2048 + O_RB(l1), cumh, dth, 1, qm, cq, mixf[1][0], mixf[1][1]);
                  else { mixf[1][0] = (bf16x8){0, 0, 0, 0, 0, 0, 0, 0}; mixf[1][1] = mixf[1][0]; } }
                f32x16 Y[2]; Y[0] = f32x16{}; Y[1] = f32x16{};
                FRESH(l2); LAS unsigned char* Cq = Cimg + qb * 2048 + O_RC(l2);
#pragma unroll
                for (int nb = 0; nb < 4; ++nb)
#pragma unroll
                    for (int tt = 0; tt < 2; ++tt) {
                        const s16x4 a0 = *(LAS s16x4*)(Cq + nb * 4096 + 32 * tt), a1 = *(LAS s16x4*)(Cq + nb * 4096 + 32 * tt + 16);
                        const bf16x8 af = (bf16x8){a0[0], a0[1], a0[2], a0[3], a1[0], a1[1], a1[2], a1[3]};
#pragma unroll
                        for (int pb = 0; pb < 2; ++pb) {
                            u32x4 pw; pw.x = pk2(hT[nb][pb][8 * tt + 0], hT[nb][pb][8 * tt + 1]); pw.y = pk2(hT[nb][pb][8 * tt + 2], hT[nb][pb][8 * tt + 3]);
                            pw.z = pk2(hT[nb][pb][8 * tt + 4], hT[nb][pb][8 * tt + 5]); pw.w = pk2(hT[nb][pb][8 * tt + 6], hT[nb][pb][8 * tt + 7]);
                            Y[pb] = __builtin_amdgcn_mfma_f32_32x32x16_bf16(af, __builtin_bit_cast(bf16x8, pw), Y[pb], 0, 0, 0);
                        }
                    }
                u32x4 zq[4];
                { FRESH(lz);
#pragma unroll
                  for (int it = 0; it < 2; ++it) { const int q = 32 * qb + 8 * it + (lz >> 3);
                      zq[it] = (q < nvalid) ? *(const u32x4*)(PROJ + (size_t)(m0 + t0 + q) * OINP + h * 64 + (lz & 7) * 8) : (u32x4){0u, 0u, 0u, 0u}; } }
#pragma unroll
                for (int g4 = 0; g4 < 4; ++g4) {
                    const f32x4 cv = *(LAS f32x4*)((LAS unsigned char*)cumv + O_H4(l2) + (32 * qb + 8 * g4) * 4);
#pragma unroll
                    for (int e = 0; e < 4; ++e) { const float f = fexp(cv[e]); Y[0][4 * g4 + e] *= f; Y[1][4 * g4 + e] *= f; }
                }
                FRESH(l3); LAS unsigned char* Xt = Xw + O_TX(l3);
#pragma unroll
                for (int sb = 0; sb < 2; ++sb)
#pragma unroll
                    for (int tp = 0; tp < 2; ++tp)
#pragma unroll
                        for (int pb = 0; pb < 2; ++pb) {
                            LAS unsigned char* xp = Xt + pb * 4096 + (32 * sb + 16 * tp) * 64;
                            const s16x4 lo = vtr(xp), h2 = vtr(xp + 512);
                            const bf16x8 xf = (bf16x8){lo[0], lo[1], lo[2], lo[3], h2[0], h2[1], h2[2], h2[3]};
                            Y[pb] = __builtin_amdgcn_mfma_f32_32x32x16_bf16(mixf[sb][tp], xf, Y[pb], 0, 0, 0);
                        }
                {
                    FRESH(l4); LAS unsigned char* yw = ystg + O_YB(l4);
#pragma unroll
                    for (int it = 2; it < 4; ++it) { const int q = 32 * qb + 8 * it + (l4 >> 3);
                        zq[it] = (q < nvalid) ? *(const u32x4*)(PROJ + (size_t)(m0 + t0 + q) * OINP + h * 64 + (l4 & 7) * 8) : (u32x4){0u, 0u, 0u, 0u}; }
#pragma unroll
                    for (int pb = 0; pb < 2; ++pb)
#pragma unroll
                        for (int r = 0; r < 16; ++r) *(LAS unsigned short*)(yw + ((r & 3) + 8 * (r >> 2)) * 128 + pb * 64) = f2bf(Y[pb][r]);
                    LDS_WAIT();
#pragma unroll
                    for (int it = 0; it < 4; ++it) {
                        const int row = 8 * it + (l4 >> 3), q = 32 * qb + row, p0 = (l4 & 7) * 8;
                        if (q < nvalid) {
                            float yv[8], xv[8], zv[8], ov[8];
                            unpack8(*(LAS u32x4*)(ystg + O_G1(l4) + it * 1024), yv);
                            unpack8(*(LAS u32x4*)(Xw + O_G2(l4) + qb * 2048 + it * 512), xv);
                            bf16_t* zp = PROJ + (size_t)(m0 + t0 + q) * OINP + h * 64 + p0;
                            unpack8(zq[it], zv);
#pragma unroll
                            for (int e = 0; e < 8; ++e) ov[e] = (yv[e] + Dh * xv[e]) * siluf_(zv[e]);
                            *(u32x4*)zp = pack8(ov);
                        }
                    }
                }
            }
            const float c63 = cumv[63];
            FRESH(l5);
#pragma unroll
            for (int it = 0; it < 8; ++it) {
                const int s = it * 8 + (l5 >> 3);
                LAS unsigned char* xp = Xw + O_G2(l5) + it * 512;
                const float w5 = dtv[s] * fexp(c63 - cumv[s]);
                float f[8]; unpack8(*(LAS u32x4*)xp, f);
#pragma unroll
                for (int e = 0; e < 8; ++e) f[e] *= w5;
                *(LAS u32x4*)xp = pack8(f);
            }
            const float dec = fexp(c63);
#pragma unroll
            for (int nb = 0; nb < 4; ++nb)
#pragma unroll
                for (int pb = 0; pb < 2; ++pb)
#pragma unroll
                    for (int r = 0; r < 16; ++r) hT[nb][pb][r] *= dec;
            LDS_WAIT();
            FRESH(l6); LAS unsigned char* X5 = Xw + O_T5(l6); LAS unsigned char* B5 = Bimg + O_T5(l6);
#pragma unroll
            for (int tt = 0; tt < 4; ++tt) {
                bf16x8 xb[2];
#pragma unroll
                for (int pb = 0; pb < 2; ++pb) {
                    LAS unsigned char* xp = X5 + pb * 4096 + tt * 1024;
                    const s16x4 lo = vtr(xp), h2 = vtr(xp + 256);
                    xb[pb] = (bf16x8){lo[0], lo[1], lo[2], lo[3], h2[0], h2[1], h2[2], h2[3]};
                }
#pragma unroll
                for (int nb = 0; nb < 4; ++nb) {
                    LAS unsigned char* bp0 = B5 + nb * 4096 + tt * 1024;
                    const s16x4 lo = vtr(bp0), h2 = vtr(bp0 + 256);
                    const bf16x8 af = (bf16x8){lo[0], lo[1], lo[2], lo[3], h2[0], h2[1], h2[2], h2[3]};
#pragma unroll
                    for (int pb = 0; pb < 2; ++pb) hT[nb][pb] = __builtin_amdgcn_mfma_f32_32x32x16_bf16(af, xb[pb], hT[nb][pb], 0, 0, 0);
                }
            }
        }
        __builtin_amdgcn_s_setprio(0);
        int lofs = r32 * 128 + 4 * hi; asm volatile("" : "+v"(lofs));
        float* sp0 = out + (isS ? O_SSM : O_PSM) + st_off + lofs;
#pragma unroll
        for (int nb = 0; nb < 4; ++nb)
#pragma unroll
            for (int pb = 0; pb < 2; ++pb) {
                float* sp = sp0 + pb * 4096 + 32 * nb;
#pragma unroll
                for (int g4 = 0; g4 < 4; ++g4) *(f32x4*)(sp + 8 * g4) = (f32x4){hT[nb][pb][4 * g4], hT[nb][pb][4 * g4 + 1], hT[nb][pb][4 * g4 + 2], hT[nb][pb][4 * g4 + 3]};
            }
    }
}

__device__ __forceinline__ void odd_norm_row(int m, int j, bf16_t* PROJ, float* out, const float* normw, int lane) {
    int b, t, L; bool isS;
    if (m < MP) { b = m >> 11; t = m & 2047; L = SEQ; isS = false; } else { const int mm = m - MP; b = mm >> 4; t = mm & 15; L = DSEQ; isS = true; }
    bf16_t* P = PROJ + (size_t)m * OINP;
    u32x4 vw[4];
#pragma unroll
    for (int gi = 0; gi < 4; ++gi) vw[gi] = *(const u32x4*)(P + gi * 512 + lane * 8);
    if (t >= L - 3) {
        float* sp = out + (isS ? O_SSMC + ((size_t)(j * DBATCH + b) * 3 + (t - (L - 3))) * 3072 : O_PSMC + ((size_t)(j * NBATCH + b) * 3 + (t - (L - 3))) * 3072);
        for (int oc = lane; oc < 384; oc += 64) {
            float v[8]; unpack8(*(const u32x4*)(P + 2048 + oc * 8), v);
            *(f32x4*)(sp + oc * 8) = (f32x4){v[0], v[1], v[2], v[3]}; *(f32x4*)(sp + oc * 8 + 4) = (f32x4){v[4], v[5], v[6], v[7]};
        }
    }
    float ssg[4];
#pragma unroll
    for (int gi = 0; gi < 4; ++gi) { float v[8]; unpack8(vw[gi], v); float ss = 0.f;
#pragma unroll
        for (int e = 0; e < 8; ++e) ss += v[e] * v[e];
        ssg[gi] = ss; }
#pragma unroll
    for (int o = 1; o < 64; o <<= 1) { ssg[0] += shx(ssg[0], o, lane); ssg[1] += shx(ssg[1], o, lane); ssg[2] += shx(ssg[2], o, lane); ssg[3] += shx(ssg[3], o, lane); }
#pragma unroll
    for (int gi = 0; gi < 4; ++gi) {
        const int c0 = gi * 512 + lane * 8;
        float v[8]; unpack8(vw[gi], v);
        const float r = frsq((ssg[gi] + EPS * 512.f) * (1.f / 512.f));
        const float* w = normw + (size_t)j * 2048 + c0;
#pragma unroll
        for (int e = 0; e < 8; ++e) v[e] = v[e] * r * w[e];
        *(u32x4*)(P + c0) = pack8(v);
    }
}


#define XB_TMO      128
#define XB_XCNT(j)  (256  + 64 * (j))
#define XB_XSUB(j)  (1280 + 64 * (j))
#define XB_XGEN(j)  (2304 + 64 * (j))
#define XB_TOP      3328
#define XB_TOPGEN   3392
#define XCD_BAR_WORDS 3456
#define XB_SPIN_CAP (1u << 22)
__device__ __forceinline__ unsigned xb_ld(unsigned* p)              { return __hip_atomic_load(p, __ATOMIC_RELAXED, __HIP_MEMORY_SCOPE_AGENT); }
__device__ __forceinline__ unsigned xb_add(unsigned* p, unsigned v) { return __hip_atomic_fetch_add(p, v, __ATOMIC_RELAXED, __HIP_MEMORY_SCOPE_AGENT); }
__device__ __forceinline__ unsigned xb_xcc_id() { return (unsigned)__builtin_amdgcn_s_getreg((3 << 11) | 20) & 0xFu; }
#define XB_SPIN(cond, bar) do { unsigned _sp = 0; while (cond) { __builtin_amdgcn_s_sleep(1); \
    if ((++_sp & 255u) == 0u) { if (xb_ld(&(bar)[XB_TMO])) break; if (_sp > XB_SPIN_CAP) { atomicAdd(&(bar)[XB_TMO], 1u); break; } } } } while (0)
struct XcdBarrier { unsigned* bar; unsigned x; volatile LAS unsigned* st; };
__device__ __forceinline__ XcdBarrier xcd_barrier_post(unsigned* bar, volatile LAS unsigned* st) {
    XcdBarrier b; b.bar = bar; b.x = xb_xcc_id(); b.st = st;
    if (threadIdx.x == 0) (void)xb_add(&bar[XB_XCNT(b.x)], 1u);
    return b;
}
__device__ __forceinline__ void xcd_barrier_complete(unsigned* bar, unsigned x, unsigned& nloc, unsigned& nx) {
    const unsigned G = gridDim.x * gridDim.y * gridDim.z;
    unsigned sum, cnt, mine, sp = 0u;
    for (;;) {
        sum = 0u; cnt = 0u; mine = 0u;
#pragma unroll
        for (unsigned j = 0; j < 16; ++j) { const unsigned c = xb_ld(&bar[XB_XCNT(j)]); sum += c; cnt += (c > 0u) ? 1u : 0u; mine = (j == x) ? c : mine; }
        if (sum == G) break;
        __builtin_amdgcn_s_sleep(1);
        if ((++sp & 255u) == 0u) { if (xb_ld(&bar[XB_TMO])) break; if (sp > XB_SPIN_CAP) { atomicAdd(&bar[XB_TMO], 1u); break; } }
    }
    nloc = mine > 0u ? mine : 1u; nx = cnt > 0u ? cnt : 1u;
}
__device__ __forceinline__ void xcd_barrier(const XcdBarrier& b) {
    asm volatile("s_waitcnt vmcnt(0)" ::: "memory");
    __syncthreads();
    if (threadIdx.x == 0) {
        unsigned* bar = b.bar;
        __builtin_amdgcn_s_waitcnt(0);
        unsigned nloc = b.st[0], nx = b.st[1];
        if (nloc == 0u) { xcd_barrier_complete(bar, b.x, nloc, nx); b.st[0] = nloc; b.st[1] = nx; }
        const unsigned old = xb_add(&bar[XB_XSUB(b.x)], 1u);
        const unsigned gen = old / nloc;
        if (old + 1u == (gen + 1u) * nloc) {
            __builtin_amdgcn_fence(__ATOMIC_RELEASE, "agent");
            asm volatile("s_waitcnt vmcnt(0)" ::: "memory");
            const unsigned og = xb_add(&bar[XB_TOP], 1u);
            const unsigned tg = og / nx;
            if (og + 1u == (tg + 1u) * nx) xb_add(&bar[XB_TOPGEN], 1u);
            else XB_SPIN(xb_ld(&bar[XB_TOPGEN]) == tg, bar);
            __builtin_amdgcn_fence(__ATOMIC_ACQUIRE, "agent");
            xb_add(&bar[XB_XGEN(b.x)], 1u);
            asm volatile("s_waitcnt vmcnt(0)" ::: "memory");
        } else {
            XB_SPIN(xb_ld(&bar[XB_XGEN(b.x)]) == gen, bar);
            __builtin_amdgcn_fence(__ATOMIC_ACQUIRE, "agent");
            asm volatile("s_waitcnt vmcnt(0)" ::: "memory");
        }
    }
    __syncthreads();
}

struct Args { const float* in[29]; float* out; unsigned char* ws; };

__global__ void __launch_bounds__(NTHREADS, 2) fwd_kernel(Args a) {
    extern __shared__ __attribute__((aligned(16))) unsigned char lds_raw[];
    LAS unsigned char* lds = (LAS unsigned char*)lds_raw;
    cg::grid_group grid = cg::this_grid();
    volatile LAS unsigned* bst = (volatile LAS unsigned*)(lds + LDS_BYTES - 16);
    if (threadIdx.x == 0) { bst[0] = 0u; bst[1] = 0u; }
    __syncthreads();
    const XcdBarrier xbar = xcd_barrier_post((unsigned*)ARG_WS, bst);
#define GRID_BAR() xcd_barrier(xbar)
    const int G = gridDim.x, ngw = G * NWAVES;
    const int wv0 = __builtin_amdgcn_readfirstlane(threadIdx.x >> 6);
#define PHASE_IDS() const int tid = ltid(wv0), lane = tid & 63, wave = __builtin_amdgcn_readfirstlane(tid >> 6), gw = blockIdx.x * NWAVES + wave; (void)tid; (void)lane; (void)gw
    (void)a;
#define out ARG_OUT
#define WEIN ((bf16_t*)(ARG_WS + WS_WEIN))
#define WEOUT ((bf16_t*)(ARG_WS + WS_WEOUT))
#define WOIN ((bf16_t*)(ARG_WS + WS_WOIN))
#define WOOUT ((bf16_t*)(ARG_WS + WS_WOOUT))
#define WUP ((bf16_t*)(ARG_WS + WS_WUP))
#define WDN ((bf16_t*)(ARG_WS + WS_WDN))
#define KS ((bf16_t*)(ARG_WS + WS_KS))
#define VS ((bf16_t*)(ARG_WS + WS_VS))
#define XN ((bf16_t*)(ARG_WS + WS_XN))
#define PROJ ((bf16_t*)(ARG_WS + WS_PROJ))

    {
        PHASE_IDS();
        LAS float* scr = (LAS float*)(lds + wave * 8448);
        constexpr int TOT = 2 * 16 * 104 + 2 * 16 * 32 + 2 * 16 * 168 + 2 * 32 * 32 + 4 * 16 * 176 + 4 * 44 * 32;
        { const float* w11 = argp(11); const float* w16 = argp(16); const float* w17 = argp(17); const float* w24 = argp(24); const float* w25 = argp(25); const float* w28 = argp(28); const float* gmix = argp(9); const float* gffn = argp(10); unsigned char* ws_ = ARG_WS;
        for (int it0 = gw; it0 < TOT; it0 += ngw) {
            int it = it0;
            if (transpose_family(it, w11, (bf16_t*)(ws_ + WS_WEIN), 2, 1024, EIN, EINP, 1, gmix, 2, 0, scr, lane)) continue;
            if (transpose_family(it, w16, (bf16_t*)(ws_ + WS_WEOUT), 2, 1024, 1024, 1024, 0, nullptr, 0, 0, scr, lane)) continue;
            if (transpose_family(it, w17, (bf16_t*)(ws_ + WS_WOIN), 2, 1024, OIN, OINP, 0, gmix, 2, 1, scr, lane)) continue;
            if (transpose_family(it, w24, (bf16_t*)(ws_ + WS_WOOUT), 2, 2048, 1024, 1024, 0, nullptr, 0, 0, scr, lane)) continue;
            if (transpose_family(it, w25, (bf16_t*)(ws_ + WS_WUP), 4, 1024, FF2, FF2, 2, gffn, 1, 0, scr, lane)) continue;
            transpose_family(it, w28, (bf16_t*)(ws_ + WS_WDN), 4, FF, 1024, 1024, 0, nullptr, 0, 0, scr, lane);
        } }
        { const float* x0 = argp(0); const float* x1 = argp(1); bf16_t* xn_ = XN; float* o_ = out; float* rs_ = (float*)(ARG_WS + WS_RS);
          for (int m = gw; m < MV; m += ngw) {
            const float* xr = (m < MP) ? x0 + (size_t)m * DM : x1 + (size_t)(m - MP) * DM;
            cast_row(xr, xn_ + (size_t)m * DM, (m < MP) ? nullptr : o_ + (size_t)m * DM, rs_ + m, lane);
          } }
    }
    grid.sync();

    for (int hl = 0; hl < 8; ++hl) {
        const int layer = hl >> 1, j = layer >> 1;
        const bool ffn = hl & 1, odd = layer & 1;
        {
            const bf16_t* Bt = ffn ? WUP + (size_t)layer * FF2 * 1024 : (odd ? WOIN + (size_t)j * OINP * 1024 : WEIN + (size_t)j * EINP * 1024);
            const int N = ffn ? FF2 : (odd ? OINP : EINP);
            pg8::Gemm g{XN, Bt, 1024, 1024, MT, N}; pg8::StaticOrder S; S.init(MP, N, 1024, G, (int)blockIdx.x, 0);
#ifndef T_NO_G1
            if (ffn) {
                pg8::EpiFfnUp E{layer};
                pg8::gemm_phase<pg8::EpiFfnUp>(lds, g, S, E, wv0);
            } else {
                pg8::EpiStoreBf16 E{PROJ, N, (const float*)(ARG_WS + WS_RS)};
                pg8::gemm_phase<pg8::EpiStoreBf16>(lds, g, S, E, wv0);
            }
#endif
        }
        GRID_BAR();
        if (ffn) {
            {
                const int gt = blockIdx.x * NTHREADS + ltid(wv0), ngt = G * NTHREADS;
                const float* THA = (const float*)(ARG_WS + WS_THA); const float* THG = (const float*)(ARG_WS + WS_THG); bf16_t* H = PROJ;
                const float* cw = argp(26) + (size_t)layer * 3 * FF; const float* cb = argp(27) + (size_t)layer * FF;
                for (int idx = gt; idx < 256 * 2 * (FF / 4); idx += ngt) {
                    const int c4 = idx % (FF / 4), r = idx / (FF / 4), rr = r & 1, pm = r >> 1;
                    if ((pm & 7) == 0) continue;
                    const int ch = c4 * 4;
                    const f32x4 cur = *(const f32x4*)(THA + ((size_t)pm * 4 + 2 + rr) * FF + ch);
                    const f32x4 l255 = *(const f32x4*)(THA + ((size_t)(pm - 1) * 4 + 1) * FF + ch);
                    const f32x4 p1 = rr ? *(const f32x4*)(THA + ((size_t)pm * 4 + 2) * FF + ch) : l255;
                    const f32x4 p2 = rr ? l255 : *(const f32x4*)(THA + ((size_t)(pm - 1) * 4 + 0) * FF + ch);
                    const f32x4 gv = *(const f32x4*)(THG + ((size_t)pm * 2 + rr) * FF + ch);
                    const f32x4 y = *(const f32x4*)(cb + ch) + *(const f32x4*)(cw + ch) * p2 + *(const f32x4*)(cw + FF + ch) * p1 + *(const f32x4*)(cw + 2 * FF + ch) * cur;
                    u32x2 w; w.x = pk2(siluf_(y.x) * gv.x, siluf_(y.y) * gv.y); w.y = pk2(siluf_(y.z) * gv.z, siluf_(y.w) * gv.w);
                    *(u32x2*)(H + (size_t)(pm * 256 + rr) * FF + ch) = w;
                }
                const float* T = (const float*)(ARG_WS + WS_TMPS); const float* st = argp(8) + (size_t)layer * DBATCH * 2 * FF; float* os = out + O_SFF + (size_t)layer * DBATCH * 2 * FF;
                for (int idx = gt; idx < MS * (FF / 4); idx += ngt) {
                    const int c4 = idx % (FF / 4), row = idx / (FF / 4), t = row & 15, bb_ = row >> 4, ch = c4 * 4;
                    const f32x4 cur = *(const f32x4*)(T + (size_t)row * 2 * FF + ch), gv = *(const f32x4*)(T + (size_t)row * 2 * FF + FF + ch);
                    const f32x4 p1 = (t >= 1) ? *(const f32x4*)(T + (size_t)(row - 1) * 2 * FF + ch) : *(const f32x4*)(st + ((size_t)bb_ * 2 + 1) * FF + ch);
                    const f32x4 p2 = (t >= 2) ? *(const f32x4*)(T + (size_t)(row - 2) * 2 * FF + ch) : *(const f32x4*)(st + ((size_t)bb_ * 2 + t) * FF + ch);
                    const f32x4 y = *(const f32x4*)(cb + ch) + *(const f32x4*)(cw + ch) * p2 + *(const f32x4*)(cw + FF + ch) * p1 + *(const f32x4*)(cw + 2 * FF + ch) * cur;
                    u32x2 w; w.x = pk2(siluf_(y.x) * gv.x, siluf_(y.y) * gv.y); w.y = pk2(siluf_(y.z) * gv.z, siluf_(y.w) * gv.w);
                    *(u32x2*)(H + (size_t)(MP + row) * FF + ch) = w;
                    if (t >= 14) *(f32x4*)(os + ((size_t)bb_ * 2 + (t - 14)) * FF + ch) = cur;
                }
            }
            GRID_BAR();
        } else if (!odd) {
            {
            PHASE_IDS();
#ifndef T_NO_PREP
            { bf16_t* pj_ = PROJ; float* o_ = out; const float* p5 = argp(5); const float* p12 = argp(12); const float* p13 = argp(13); const float* p14 = argp(14); const float* p15 = argp(15); bf16_t* ks_ = KS; bf16_t* vs_ = VS;
              for (int m = gw; m < MV; m += ngw) even_prep_row(m, j, pj_, o_, p5, p12, p13, p14, p15, ks_, vs_, lane); }
#endif
            {
                const int gt = blockIdx.x * NTHREADS + tid, ngt = G * NTHREADS; const float* ck_ = argp(2); const float* cv_ = argp(3); bf16_t* ks_ = KS; bf16_t* vs_ = VS;
                for (int idx = gt; idx < DBATCH * PAST * 64; idx += ngt) {
                    const int bb = idx >> 16, rem = idx & 65535, i = rem >> 6, c8 = rem & 63;
                    const size_t so = ((size_t)(j * DBATCH + bb) * PAST + i) * 512 + c8 * 8; const size_t dof = ((size_t)bb * KSROWS + i) * 512 + c8 * 8;
                    { const f32x4 x = *(const f32x4*)(ck_ + so), y = *(const f32x4*)(ck_ + so + 4); u32x4 w; w.x = pk2(x.x, x.y); w.y = pk2(x.z, x.w); w.z = pk2(y.x, y.y); w.w = pk2(y.z, y.w); *(u32x4*)(ks_ + dof) = w; }
                    { const f32x4 x = *(const f32x4*)(cv_ + so), y = *(const f32x4*)(cv_ + so + 4); u32x4 w; w.x = pk2(x.x, x.y); w.y = pk2(x.z, x.w); w.z = pk2(y.x, y.y); w.w = pk2(y.z, y.w); *(u32x4*)(vs_ + dof) = w; }
                }
                for (int idx = gt; idx < DBATCH * 48 * 64; idx += ngt) {
                    const int bb = idx / (48 * 64), rem = idx % (48 * 64), i = 1040 + (rem >> 6), c8 = rem & 63;
                    const size_t dof = ((size_t)bb * KSROWS + i) * 512 + c8 * 8;
                    *(u32x4*)(ks_ + dof) = (u32x4){0u, 0u, 0u, 0u}; *(u32x4*)(vs_ + dof) = (u32x4){0u, 0u, 0u, 0u};
                }
            }
            }
            GRID_BAR();
#ifndef T_NO_ATT
            for (int u = blockIdx.x; u < 2048 + 64; u += G) {
                if (u < 2048) {
                    const int qb = 7 - (u >> 8), bh = u & 255, b = bh >> 3, h = bh & 7;
                    bf16_t* base = PROJ + (size_t)(b * SEQ) * EINP + h * 64;
                    attn_unit(lds, base + (size_t)(256 * qb) * EINP + 1536, EINP, base + 2048, base + 2560, EINP, 256, 256 * qb, 256 * (qb + 1),
                              nullptr, 0, out + O_PLF + ((size_t)(j * NBATCH + b) * SEQ) * 8 + h, 8, wv0, (G == 256) && (u >= G));
                } else {
                    const int idx = u - 2048, b = idx >> 3, h = idx & 7;
                    bf16_t* base = PROJ + (size_t)(MP + DSEQ * b) * EINP + h * 64;
                    attn_unit(lds, base + 1536, EINP, KS + (size_t)b * KSROWS * 512 + h * 64, VS + (size_t)b * KSROWS * 512 + h * 64, 512, DSEQ, PAST, PAST + DSEQ,
                              argp(4) + ((size_t)(j * DBATCH + b) * PAST) * 8 + h, PAST, out + O_SLF + ((size_t)(j * DBATCH + b) * DSEQ) * 8 + h, 1, wv0, false);
                }
            }
#endif
            GRID_BAR();
        } else {
#ifndef T_NO_SSD
            for (int u = blockIdx.x; u < 256 + 64; u += G) {
                const bool isS = u >= 256; const int idx = isS ? u - 256 : u;
                ssd_unit(lds, j, idx >> 3, (idx >> 1) & 3, idx & 1, isS, PROJ, out, argp(6), argp(7), argp(18), argp(19), argp(20), argp(21), argp(22), wv0);
            }
#endif
            GRID_BAR();
            { PHASE_IDS(); bf16_t* pj_ = PROJ; float* o_ = out; const float* p23 = argp(23); for (int m = gw; m < MV; m += ngw) odd_norm_row(m, j, pj_, o_, p23, lane); }
            GRID_BAR();
        }
        {
            const bf16_t* A = (ffn || odd) ? PROJ : PROJ + 1024;
            const int lda = ffn ? FF : (odd ? OINP : EINP);
            const int K = ffn ? FF : (odd ? 2048 : 1024);
            const bf16_t* Bt = ffn ? WDN + (size_t)layer * 1024 * FF : (odd ? WOOUT + (size_t)j * 1024 * 2048 : WEOUT + (size_t)j * 1024 * 1024);
            pg8::Gemm g{A, Bt, lda, K, MT, 1024}; pg8::StaticOrder S; S.init(MP, 1024, K, G, (int)blockIdx.x, 4);
            pg8::EpiResid E{out, XN, (float*)(ARG_WS + WS_SS), MV, K / 64, hl == 7};
#ifndef T_NO_G2
            pg8::gemm_phase<pg8::EpiResid>(lds, g, S, E, wv0);
#endif
        }
        GRID_BAR();
        if (hl < 7) {
            PHASE_IDS();
            float* o_ = out; bf16_t* xn_ = XN; const float* ss_ = (const float*)(ARG_WS + WS_SS); float* rs_ = (float*)(ARG_WS + WS_RS);
            { const int m = MP + gw; if (m < MV) cast_row(o_ + (size_t)m * DM, xn_ + (size_t)m * DM, nullptr, rs_ + m, lane); }
            int gstr = G * NTHREADS; asm volatile("" : "+s"(gstr));
#pragma unroll 1
            for (int m = blockIdx.x * NTHREADS + tid; m < MP; m += gstr) {
                const f32x4* sp = (const f32x4*)(ss_ + (size_t)m * 16); const f32x4 s0 = sp[0], s1 = sp[1], s2 = sp[2], s3 = sp[3];
                const float tot = ((s0.x + s0.y) + (s0.z + s0.w)) + ((s1.x + s1.y) + (s1.z + s1.w)) + ((s2.x + s2.y) + (s2.z + s2.w)) + ((s3.x + s3.y) + (s3.z + s3.w));
                rs_[m] = frsq((tot + EPS * DM) * (1.f / DM));
            }
            GRID_BAR();
        }
    }
#undef out
#undef WEIN
#undef WEOUT
#undef WOIN
#undef WOOUT
#undef WUP
#undef WDN
#undef KS
#undef VS
#undef XN
#undef PROJ
}

extern "C" void kernel_launch(void* const* d_in, const int* in_sizes, int n_in, void* d_out, int out_size, void* d_ws, size_t ws_size, hipStream_t stream) {
    static int grid = 0;
    if (grid == 0) {
        if (n_in != 29 || (size_t)out_size != O_END || ws_size < WS_END) { fprintf(stderr, "kernel_launch: unexpected sizes n_in %d out %d (want %zu) ws %zu (want %zu)\n", n_in, out_size, (size_t)O_END, ws_size, (size_t)WS_END); grid = -1; return; }
        int dev = 0, cus = 0, per_cu = 0;
        hipGetDevice(&dev); hipDeviceGetAttribute(&cus, hipDeviceAttributeMultiprocessorCount, dev);
        if (hipFuncSetAttribute((const void*)fwd_kernel, hipFuncAttributeMaxDynamicSharedMemorySize, LDS_BYTES) != hipSuccess) { fprintf(stderr, "kernel_launch: hipFuncSetAttribute failed\n"); grid = -1; return; }
        if (hipOccupancyMaxActiveBlocksPerMultiprocessor(&per_cu, (const void*)fwd_kernel, NTHREADS, LDS_BYTES) != hipSuccess || per_cu < 1) { fprintf(stderr, "kernel_launch: occupancy query says %d\n", per_cu); per_cu = 1; }
        (void)hipGetLastError();
        grid = cus;
        fprintf(stderr, "kernel_launch: grid %d (cus %d, per_cu %d)\n", grid, cus, per_cu);
    }
    if (grid < 0) return;
    if (hipMemsetAsync(d_ws, 0, 16384, stream) != hipSuccess) { fprintf(stderr, "kernel_launch: memset of barrier words failed\n"); return; }
    Args a{};
    for (int i = 0; i < 29; ++i) a.in[i] = (const float*)d_in[i];
    a.out = (float*)d_out; a.ws = (unsigned char*)d_ws;
    void* args[] = {&a};
    hipError_t e = hipLaunchCooperativeKernel((const void*)fwd_kernel, dim3(grid), dim3(NTHREADS), args, LDS_BYTES, stream);
    if (e != hipSuccess) fprintf(stderr, "cooperative launch failed: %s (grid %d)\n", hipGetErrorString(e), grid);
}
```
